# Optimizing an MI355X kernel written in HIP

```python
import math
import jax, jax.numpy as jnp
from jax import lax
import numpy as np

D_MODEL = 1024
BATCH = 16
SEQ = 2048
DEPTH = 1
DEC_BATCH = 32
DEC_SEQ = 32
PAST_LEN = 2048

CHUNK = 64
Q_BLOCK = 128
N_HEADS_A = D_MODEL // 256
HEAD_DIM_A = 64
V_DIM_A = 2 * HEAD_DIM_A
QK_WIDTH = N_HEADS_A * 2 * HEAD_DIM_A
WIDTH_A = N_HEADS_A * V_DIM_A
WIDTH_B = D_MODEL - WIDTH_A
A_COLS = 2 * QK_WIDTH + WIDTH_A
IN_COLS = A_COLS + 2 * WIDTH_B
CONV_WIDTH = 31
CONV_PAD = CONV_WIDTH - 1
D_FF = 4 * D_MODEL
N_BUCKETS = 32
MAX_DISTANCE = 128
EPS = 1e-6
NEG_INF = -1e30

kernel_name = 'hymba_diffattn_conformer_stream_step'


def _rms_norm(x, g):
    xf = x.astype(jnp.float32)
    y = xf * lax.rsqrt(jnp.mean(xf * xf, axis=-1, keepdims=True) + EPS)
    return (y * g.astype(jnp.float32)).astype(x.dtype)


def _layer_norm(x, g, b):
    xf = x.astype(jnp.float32)
    mu = jnp.mean(xf, axis=-1, keepdims=True)
    var = jnp.mean(jnp.square(xf - mu), axis=-1, keepdims=True)
    y = (xf - mu) * lax.rsqrt(var + EPS)
    return (y * g.astype(jnp.float32) + b.astype(jnp.float32)).astype(x.dtype)


def _rel_bucket(rel):
    half = N_BUCKETS // 2
    max_exact = half // 2
    n = -rel
    ret = jnp.where(n < 0, half, 0)
    n = jnp.abs(n)
    nf = jnp.maximum(n, 1).astype(jnp.float32)
    large = max_exact + (jnp.log(nf / max_exact) / math.log(MAX_DISTANCE / max_exact)
                         * (half - max_exact)).astype(jnp.int32)
    large = jnp.minimum(large, half - 1)
    return ret + jnp.where(n < max_exact, n, large)


def _diff_attention(q, k, v, past_len, rel_bias, lam, subln_g, lam_init):
    B, T = q.shape[0], q.shape[1]
    n_keys = k.shape[1]
    scale = HEAD_DIM_A ** -0.5
    qh = q.reshape(B, T, N_HEADS_A, 2, HEAD_DIM_A) * scale
    kh = k.reshape(B, n_keys, N_HEADS_A, 2, HEAD_DIM_A)
    outs = []
    for start in range(0, T, Q_BLOCK):
        stop = min(start + Q_BLOCK, T)
        k_end = past_len + stop
        q_pos = past_len + jnp.arange(start, stop)
        k_pos = jnp.arange(k_end)
        bias = rel_bias[_rel_bucket(k_pos[None, :] - q_pos[:, None])]
        bias = jnp.transpose(bias, (2, 0, 1)).astype(jnp.float32)
        mask = (k_pos[None, :] // CHUNK) <= (q_pos[:, None] // CHUNK)
        s = jnp.einsum('bqhmd,bkhmd->bhmqk', qh[:, start:stop], kh[:, :k_end]).astype(jnp.float32)
        s = jnp.where(mask, s + bias[None, :, None], NEG_INF)
        p = jax.nn.softmax(s, axis=-1)
        attn = p[:, :, 0] - lam * p[:, :, 1]
        outs.append(jnp.einsum('bhqk,bkhd->bqhd', attn.astype(v.dtype), v[:, :k_end]))
    o = jnp.concatenate(outs, axis=1)
    o = _rms_norm(o, subln_g) * (1.0 - lam_init)
    return o.reshape(B, T, WIDTH_A)


def _causal_depthwise_conv(u_full, w_dw, b_dw):
    y = lax.conv_general_dilated(u_full, w_dw[:, None, :].astype(u_full.dtype), window_strides=(1,),
                                 padding='VALID', dimension_numbers=('NWC', 'WIO', 'NWC'),
                                 feature_group_count=WIDTH_B)
    return y + b_dw


def _layer(x, past_k, past_v, conv_prefix, rel_bias, lam_init, ln1_g, w_in, lq1, lk1, lq2, lk2,
           subln_g, w_dw, b_dw, cln_g, cln_b, w_out, ln2_g, w_up, w_down):
    B, T, _ = x.shape
    h = _rms_norm(x, ln1_g)
    proj = h @ w_in
    q = proj[..., :QK_WIDTH].reshape(B, T, N_HEADS_A, 2 * HEAD_DIM_A)
    k = proj[..., QK_WIDTH:2 * QK_WIDTH].reshape(B, T, N_HEADS_A, 2 * HEAD_DIM_A)
    v = proj[..., 2 * QK_WIDTH:A_COLS].reshape(B, T, N_HEADS_A, V_DIM_A)
    u = proj[..., A_COLS:A_COLS + WIDTH_B] * jax.nn.sigmoid(proj[..., A_COLS + WIDTH_B:])
    if past_k is None:
        past_len, k_all, v_all = 0, k, v
    else:
        past_len = past_k.shape[1]
        k_all = jnp.concatenate([past_k, k], axis=1)
        v_all = jnp.concatenate([past_v, v], axis=1)
    f32 = jnp.float32
    lam = (jnp.exp(jnp.sum(lq1.astype(f32) * lk1.astype(f32)))
           - jnp.exp(jnp.sum(lq2.astype(f32) * lk2.astype(f32))) + lam_init)
    a = _diff_attention(q, k_all, v_all, past_len, rel_bias, lam, subln_g, lam_init)
    u_full = jnp.concatenate([conv_prefix.astype(u.dtype), u], axis=1)
    c = _layer_norm(_causal_depthwise_conv(u_full, w_dw, b_dw), cln_g, cln_b)
    c = c * jax.nn.sigmoid(c)
    x = x + jnp.concatenate([a, c], axis=-1) @ w_out
    h2 = _rms_norm(x, ln2_g)
    x = x + jnp.square(jax.nn.relu(h2 @ w_up)) @ w_down
    return x, k, v, u_full[:, -CONV_PAD:]


def setup_inputs(seed: int = 0) -> dict:
    key = jax.random.key(seed)
    ks = jax.random.split(key, 24)
    n = jax.random.normal
    f = jnp.float32
    H = N_HEADS_A
    return {
        'x_prompt': n(ks[0], (BATCH, SEQ, D_MODEL), f),
        'x_sample': n(ks[1], (DEC_BATCH, DEC_SEQ, D_MODEL), f),
        'cache_k': n(ks[2], (DEPTH, DEC_BATCH, PAST_LEN, H, 2 * HEAD_DIM_A), f),
        'cache_v': n(ks[3], (DEPTH, DEC_BATCH, PAST_LEN, H, V_DIM_A), f),
        'state_conv': 0.5 * n(ks[4], (DEPTH, DEC_BATCH, CONV_PAD, WIDTH_B), f),
        'rel_bias': 0.5 * n(ks[5], (N_BUCKETS, H), f),
        'ln1_g': 1.0 + 0.05 * n(ks[6], (DEPTH, D_MODEL), f),
        'w_in': n(ks[7], (DEPTH, D_MODEL, IN_COLS), f) * D_MODEL ** -0.5,
        'lambda_q1': 0.1 * n(ks[8], (DEPTH, HEAD_DIM_A), f),
        'lambda_k1': 0.1 * n(ks[9], (DEPTH, HEAD_DIM_A), f),
        'lambda_q2': 0.1 * n(ks[10], (DEPTH, HEAD_DIM_A), f),
        'lambda_k2': 0.1 * n(ks[11], (DEPTH, HEAD_DIM_A), f),
        'subln_g': 1.0 + 0.05 * n(ks[12], (DEPTH, V_DIM_A), f),
        'w_dw': n(ks[13], (DEPTH, CONV_WIDTH, WIDTH_B), f) * CONV_WIDTH ** -0.5,
        'b_dw': 0.02 * n(ks[14], (DEPTH, WIDTH_B), f),
        'conv_ln_g': 1.0 + 0.05 * n(ks[15], (DEPTH, WIDTH_B), f),
        'conv_ln_b': 0.02 * n(ks[16], (DEPTH, WIDTH_B), f),
        'w_out': n(ks[17], (DEPTH, WIDTH_A + WIDTH_B, D_MODEL), f) * (WIDTH_A + WIDTH_B) ** -0.5,
        'ln2_g': 1.0 + 0.05 * n(ks[18], (DEPTH, D_MODEL), f),
        'w_up': n(ks[19], (DEPTH, D_MODEL, D_FF), f) * D_MODEL ** -0.5,
        'w_down': n(ks[20], (DEPTH, D_FF, D_MODEL), f) * D_FF ** -0.5,
        'ln_f_g': 1.0 + 0.05 * n(ks[21], (D_MODEL,), f),
    }


def reference(x_prompt, x_sample, cache_k, cache_v, state_conv, rel_bias, ln1_g, w_in,
              lambda_q1, lambda_k1, lambda_q2, lambda_k2, subln_g, w_dw, b_dw, conv_ln_g,
              conv_ln_b, w_out, ln2_g, w_up, w_down, ln_f_g):
    yp, ys = x_prompt, x_sample
    kp, vp, cp, ksm, vsm, csm = [], [], [], [], [], []
    for l in range(DEPTH):
        lam_init = 0.8 - 0.6 * math.exp(-0.3 * l)
        wts = (ln1_g[l], w_in[l], lambda_q1[l], lambda_k1[l], lambda_q2[l], lambda_k2[l],
               subln_g[l], w_dw[l], b_dw[l], conv_ln_g[l], conv_ln_b[l], w_out[l], ln2_g[l],
               w_up[l], w_down[l])
        zero_prefix = jnp.zeros((yp.shape[0], CONV_PAD, WIDTH_B), yp.dtype)
        yp, k1, v1, c1 = _layer(yp, None, None, zero_prefix, rel_bias, lam_init, *wts)
        ys, k2, v2, c2 = _layer(ys, cache_k[l], cache_v[l], state_conv[l], rel_bias, lam_init, *wts)
        kp.append(k1); vp.append(v1); cp.append(c1)
        ksm.append(k2); vsm.append(v2); csm.append(c2)
    yp = _rms_norm(yp, ln_f_g)
    ys = _rms_norm(ys, ln_f_g)
    return (yp, ys, jnp.stack(kp), jnp.stack(vp), jnp.stack(cp), jnp.stack(ksm), jnp.stack(vsm), jnp.stack(csm))
```

```cpp
#include <hip/hip_runtime.h>
#include <hip/hip_bf16.h>
#include <cstdio>
#include <cstdint>
#include <cmath>
namespace pg8 {
#define PG8_LAS __attribute__((address_space(3)))
typedef unsigned short bf16_t;
typedef short bf16x8 __attribute__((ext_vector_type(8)));
typedef float f32x4 __attribute__((ext_vector_type(4)));
typedef unsigned u32x4 __attribute__((ext_vector_type(4)));
constexpr int BM = 256, BK = 64, HALF = 128, HTB = HALF * BK * 2  , STAGE_BYTES = 8 * HTB, NXCD = 8, WGM = 8;

__host__ __device__ __forceinline__ int lds_byte(int r, int c) { const int st = (r >> 4) * 2 + (c >> 5), rr = r & 15, cc = c & 31, ob = rr * 64 + cc * 2; return st * 1024 + (ob ^ (((ob >> 9) & 1) << 5)); }
__host__ __device__ __forceinline__ void stage_rc(int b, int& R, int& C) { const int st = b / 1024, sb = b % 1024, swz = sb ^ (((sb >> 9) & 1) << 5); R = (st >> 1) * 16 + swz / 64; C = (st & 1) * 32 + (swz % 64) / 2; }
__host__ __device__ __forceinline__ int perm32(int rho) { const int n = rho >> 4, i = rho & 15; return 8 * (i >> 2) + 4 * n + (i & 3); }

struct Unit { int pm, pn; };
struct Gemm { const bf16_t* A; const bf16_t* Bt; int M, N, K; };

struct StaticOrder {
    int nM, nN, nwg, G, c;
    __host__ __device__ void init(int M, int N, int G_, int c_) { nM = M / BM; nN = N / BM; nwg = nM * nN; G = G_; c = c_; }
    __host__ __device__ bool next(int i, Unit& u) const {
        const long L = (long)i * G + c; if (L >= nwg) return false;
        int wgid = (int)L; { const int q = nwg / NXCD, r = nwg % NXCD, xcd = wgid % NXCD, off = wgid / NXCD; wgid = (xcd < r ? xcd * (q + 1) : r * (q + 1) + (xcd - r) * q) + off; }
        const int nig = WGM * nN, gid = wgid / nig, fm = gid * WGM, gsz = (nM - fm) < WGM ? (nM - fm) : WGM;
        u.pm = fm + ((wgid % nig) % gsz); u.pn = (wgid % nig) / gsz; return true;
    }
    __device__ __forceinline__ void a_ready(const Unit&) const {}
    __device__ __forceinline__ void done(const Unit&) const {}
};


__device__ __forceinline__ unsigned cvt_pk_bf16(float lo, float hi) { unsigned r; asm volatile("v_cvt_pk_bf16_f32 %0, %1, %2" : "=v"(r) : "v"(lo), "v"(hi)); return r; }
__device__ __forceinline__ u32x4 pack8(const f32x4 v0, const f32x4 v1) { u32x4 w; w.x = cvt_pk_bf16(v0[0], v0[1]); w.y = cvt_pk_bf16(v0[2], v0[3]); w.z = cvt_pk_bf16(v1[0], v1[1]); w.w = cvt_pk_bf16(v1[2], v1[3]); return w; }
__device__ __forceinline__ float sigmoidf_fast(float g) { return __builtin_amdgcn_rcpf(1.0f + __builtin_amdgcn_exp2f(-1.4426950408889634f * g)); }

constexpr int PROMPT_ROWS = 32768;
constexpr int KC_ROWS = 2112;

struct EpiProj {
    static constexpr bool PERM = true, AFTER_DRAIN = false;
    bf16_t *Q, *Kp, *Vp, *Kc, *Vc, *U; float *okp, *ovp, *oks, *ovs; float qscale;
    __device__ __forceinline__ void operator()(const f32x4 (&acc)[2][2][4][2], const Unit& u, int wr, int wc, int fr, int fq) const {
        const int pn = u.pn; const bool sample = u.pm >= PROMPT_ROWS / BM;
        const int row0 = u.pm * BM + wr * 64 + fr, cl = wc * 32 + 8 * fq;
        if (pn < 2) {
#pragma unroll
            for (int ai = 0; ai < 2; ++ai)
#pragma unroll
                for (int m = 0; m < 4; ++m) { bf16_t* rp = Q + (size_t)(row0 + ai * HALF + m * 16) * 512 + pn * 256 + cl;
#pragma unroll
                    for (int bj = 0; bj < 2; ++bj) *(u32x4*)(rp + bj * HALF) = pack8(acc[ai][bj][m][0] * qscale, acc[ai][bj][m][1] * qscale); }
        } else if (pn < 6) {
            const bool isV = pn >= 4; const int c0 = (pn & 1) * 256 + cl;
#pragma unroll
            for (int ai = 0; ai < 2; ++ai)
#pragma unroll
                for (int m = 0; m < 4; ++m) { const int R = row0 + ai * HALF + m * 16; bf16_t* bp; float* fp;
                    if (!sample) { bp = (isV ? Vp : Kp) + (size_t)R * 512 + c0; fp = (isV ? ovp : okp) + (size_t)R * 512 + c0; }
                    else { const int s = R - PROMPT_ROWS, b = s >> 5, t = s & 31; bp = (isV ? Vc : Kc) + (size_t)(b * KC_ROWS + 2048 + t) * 512 + c0; fp = (isV ? ovs : oks) + (size_t)s * 512 + c0; }
#pragma unroll
                    for (int bj = 0; bj < 2; ++bj) { const f32x4 v0 = acc[ai][bj][m][0], v1 = acc[ai][bj][m][1];
                        *(u32x4*)(bp + bj * HALF) = pack8(v0, v1); *(f32x4*)(fp + bj * HALF) = v0; *(f32x4*)(fp + bj * HALF + 4) = v1; } }
        } else {
            const int c0 = (pn - 6) * 128 + cl;
#pragma unroll
            for (int ai = 0; ai < 2; ++ai)
#pragma unroll
                for (int m = 0; m < 4; ++m) { const int R = row0 + ai * HALF + m * 16; f32x4 o0, o1;
#pragma unroll
                    for (int i = 0; i < 4; ++i) { o0[i] = acc[ai][0][m][0][i] * sigmoidf_fast(acc[ai][1][m][0][i]); o1[i] = acc[ai][0][m][1][i] * sigmoidf_fast(acc[ai][1][m][1][i]); }
                    *(u32x4*)(U + (size_t)R * 512 + c0) = pack8(o0, o1); }
        }
    }
};
struct EpiResF32 {
    static constexpr bool PERM = false, AFTER_DRAIN = false;
    const float* resP; const float* resS; float* out;
    __device__ __forceinline__ void operator()(const f32x4 (&acc)[2][2][4][2], const Unit& u, int wr, int wc, int fr, int fq) const {
        const int row0 = u.pm * BM + wr * 64 + fr, col0 = u.pn * BM + wc * 32 + 4 * fq;
        const float* rbase = (u.pm >= PROMPT_ROWS / BM) ? resS - (size_t)PROMPT_ROWS * 1024 : resP;
#pragma unroll
        for (int ai = 0; ai < 2; ++ai)
#pragma unroll
            for (int m = 0; m < 4; ++m) { const size_t off = (size_t)(row0 + ai * HALF + m * 16) * 1024 + col0;
#pragma unroll
                for (int bj = 0; bj < 2; ++bj)
#pragma unroll
                    for (int n = 0; n < 2; ++n) { const f32x4 r = *(const f32x4*)(rbase + off + bj * HALF + n * 16); *(f32x4*)(out + off + bj * HALF + n * 16) = r + acc[ai][bj][m][n]; } }
    }
};
struct EpiRelu2 {
    static constexpr bool PERM = true, AFTER_DRAIN = false;
    bf16_t* O; int ldc;
    __device__ __forceinline__ void operator()(const f32x4 (&acc)[2][2][4][2], const Unit& u, int wr, int wc, int fr, int fq) const {
        const int row0 = u.pm * BM + wr * 64 + fr, col0 = u.pn * BM + wc * 32 + 8 * fq;
#pragma unroll
        for (int ai = 0; ai < 2; ++ai)
#pragma unroll
            for (int m = 0; m < 4; ++m) { bf16_t* rp = O + (size_t)(row0 + ai * HALF + m * 16) * ldc + col0;
#pragma unroll
                for (int bj = 0; bj < 2; ++bj) { f32x4 v0 = acc[ai][bj][m][0], v1 = acc[ai][bj][m][1];
#pragma unroll
                    for (int i = 0; i < 4; ++i) { const float a = fmaxf(v0[i], 0.f), b = fmaxf(v1[i], 0.f); v0[i] = a * a; v1[i] = b * b; }
                    *(u32x4*)(rp + bj * HALF) = pack8(v0, v1); } }
    }
};

template <class Epi, class Sched, bool ALIGN_EPI = false, bool SP2 = false>
__device__ __forceinline__ void gemm_phase(PG8_LAS unsigned char* lds, const Gemm g, const Sched& S, const Epi& E) {
    const int tid = threadIdx.x, wid = __builtin_amdgcn_readfirstlane(tid >> 6), lane = tid & 63, wr = wid >> 2, wc = wid & 3, fr = lane & 15, fq = lane >> 4;
    const int K = g.K, nt = K / BK;
    unsigned voffA[2], voffB[2];
#pragma unroll
    for (int i = 0; i < 2; ++i) { int R, C; stage_rc(tid * 16 + i * 8192, R, C); const int Rb = Epi::PERM ? ((R & ~31) + perm32(R & 31)) : R;
        voffA[i] = (unsigned)(R * K + C) * 2u; voffB[i] = (unsigned)(Rb * K + C) * 2u; }
    const size_t kstep = (size_t)(BK * 2);
    const size_t hstep = (size_t)HALF * K * 2;
    const size_t tstep = 2 * hstep;
    const unsigned ldsw = (unsigned)wid * 1024u;
    const int aoff = lds_byte(wr * 64 + fr, fq * 8), boff = lds_byte(wc * 32 + fr, fq * 8);
#define PG8_SA(b, h) (((b) * 2 + (h)) * HTB)
#define PG8_SB(b, h) ((4 + (b) * 2 + (h)) * HTB)
#define PG8_STAGE(bufoff, gbase, voff) do { _Pragma("unroll") for (int _i = 0; _i < 2; ++_i) \
        __builtin_amdgcn_global_load_lds((const unsigned*)((const char*)(gbase) + (voff)[_i]), (PG8_LAS unsigned*)(lds + (bufoff) + ldsw + _i * 8192), 16, 0, 0); } while (0)
#define PG8_LDA(dst, b, h) do { _Pragma("unroll") for (int m = 0; m < 4; ++m) _Pragma("unroll") for (int k = 0; k < 2; ++k) dst[m][k] = *(const PG8_LAS bf16x8*)(lds + PG8_SA(b, h) + aoff + m * 2048 + k * 1024); } while (0)
#define PG8_LDB(dst, b, h) do { _Pragma("unroll") for (int n = 0; n < 2; ++n) _Pragma("unroll") for (int k = 0; k < 2; ++k) dst[n][k] = *(const PG8_LAS bf16x8*)(lds + PG8_SB(b, h) + boff + n * 2048 + k * 1024); } while (0)
#define PG8_MMA(ai, bj, At, Bt) do { __builtin_amdgcn_s_setprio(1); _Pragma("unroll") for (int m = 0; m < 4; ++m) _Pragma("unroll") for (int n = 0; n < 2; ++n) _Pragma("unroll") for (int k = 0; k < 2; ++k) \
        acc[ai][bj][m][n] = __builtin_amdgcn_mfma_f32_16x16x32_bf16(Bt[n][k], At[m][k], acc[ai][bj][m][n], 0, 0, 0); __builtin_amdgcn_s_setprio(0); } while (0)
#define PG8_WAIT_V(n) asm volatile("s_waitcnt vmcnt(" #n ")" ::: "memory")
#define PG8_WAIT_L(n) asm volatile("s_waitcnt lgkmcnt(" #n ")" ::: "memory")
#define PG8_BAR __builtin_amdgcn_s_barrier()
#define PG8_SCHED __builtin_amdgcn_sched_barrier(0)
    Unit cur, nxt; int ui = 0;
    if (!S.next(0, cur)) return;
    f32x4 acc[2][2][4][2];
#pragma unroll
    for (int a = 0; a < 2; ++a)
#pragma unroll
        for (int b = 0; b < 2; ++b)
#pragma unroll
            for (int m = 0; m < 4; ++m)
#pragma unroll
                for (int n = 0; n < 2; ++n) acc[a][b][m][n] = (f32x4){0.f, 0.f, 0.f, 0.f};
    bf16x8 At[4][2], B0[2][2], B1[2][2];
    const char* cA = (const char*)g.A + (size_t)cur.pm * tstep; const char* cB = (const char*)g.Bt + (size_t)cur.pn * tstep;
    S.a_ready(cur);
    if constexpr (SP2) {
        PG8_STAGE(PG8_SB(0, 0), cB, voffB); PG8_STAGE(PG8_SB(0, 1), cB + hstep, voffB); PG8_STAGE(PG8_SA(0, 0), cA, voffA); PG8_STAGE(PG8_SA(0, 1), cA + hstep, voffA);
        if (wr == 1) PG8_BAR;
        PG8_WAIT_V(2); PG8_BAR;
        PG8_STAGE(PG8_SB(1, 0), cB + kstep, voffB); PG8_STAGE(PG8_SA(1, 0), cA + kstep, voffA); PG8_STAGE(PG8_SB(1, 1), cB + hstep + kstep, voffB);
        PG8_WAIT_V(6); PG8_BAR;
    } else {
        PG8_STAGE(PG8_SB(0, 0), cB, voffB); PG8_STAGE(PG8_SA(0, 0), cA, voffA); PG8_STAGE(PG8_SB(0, 1), cB + hstep, voffB); PG8_STAGE(PG8_SA(0, 1), cA + hstep, voffA);
        if (wr == 1) PG8_BAR;
        PG8_WAIT_V(4); PG8_BAR;
        PG8_STAGE(PG8_SB(1, 0), cB + kstep, voffB); PG8_STAGE(PG8_SA(1, 0), cA + kstep, voffA); PG8_STAGE(PG8_SB(1, 1), cB + hstep + kstep, voffB);
        PG8_WAIT_V(6); PG8_BAR;
    }
    for (;;) {
        const bool has_next = S.next(ui + 1, nxt);
        const char* nA = has_next ? (const char*)g.A + (size_t)nxt.pm * tstep : cA; const char* nB = has_next ? (const char*)g.Bt + (size_t)nxt.pn * tstep : cB;
        for (int t = 0; t < nt; t += 2) {
            const bool last = (t == nt - 2);
            const char* a1 = cA + (size_t)(t + 1) * kstep;
            const char* a2 = last ? nA : cA + (size_t)(t + 2) * kstep; const char* b2 = last ? nB : cB + (size_t)(t + 2) * kstep;
            const char* a3 = a2 + kstep; const char* b3 = b2 + kstep;
            if (last && has_next) S.a_ready(nxt);
            if constexpr (SP2) {
            PG8_LDB(B0, 0, 0); PG8_LDB(B1, 0, 1); PG8_SCHED; PG8_LDA(At, 0, 0); PG8_STAGE(PG8_SA(1, 1), a1 + hstep, voffA);
            PG8_WAIT_V(8); PG8_WAIT_L(0); PG8_BAR; PG8_MMA(0, 0, At, B0); PG8_MMA(0, 1, At, B1); PG8_BAR; PG8_SCHED;
            PG8_LDA(At, 0, 1); PG8_STAGE(PG8_SB(0, 0), b2, voffB); PG8_STAGE(PG8_SB(0, 1), b2 + hstep, voffB); PG8_STAGE(PG8_SA(0, 0), a2, voffA);
            PG8_WAIT_V(8); PG8_WAIT_L(0); PG8_BAR; PG8_MMA(1, 0, At, B0); PG8_MMA(1, 1, At, B1); PG8_BAR; PG8_SCHED;
            PG8_LDB(B0, 1, 0); PG8_LDB(B1, 1, 1); PG8_SCHED; PG8_LDA(At, 1, 0); PG8_STAGE(PG8_SA(0, 1), a2 + hstep, voffA);
            PG8_WAIT_V(8); PG8_WAIT_L(0); PG8_BAR; PG8_MMA(0, 0, At, B0); PG8_MMA(0, 1, At, B1); PG8_BAR; PG8_SCHED;
            PG8_LDA(At, 1, 1); PG8_STAGE(PG8_SB(1, 0), b3, voffB); PG8_STAGE(PG8_SB(1, 1), b3 + hstep, voffB); PG8_STAGE(PG8_SA(1, 0), a3, voffA);
            PG8_WAIT_V(8); PG8_WAIT_L(0); PG8_BAR; PG8_MMA(1, 0, At, B0); PG8_MMA(1, 1, At, B1); PG8_BAR; PG8_SCHED;
            } else {
            PG8_LDB(B0, 0, 0); PG8_SCHED; PG8_LDA(At, 0, 0); PG8_STAGE(PG8_SA(1, 1), a1 + hstep, voffA);
            PG8_WAIT_L(8); PG8_BAR; PG8_WAIT_L(0); PG8_MMA(0, 0, At, B0); PG8_BAR; PG8_SCHED;
            PG8_LDB(B1, 0, 1); PG8_STAGE(PG8_SB(0, 0), b2, voffB);
            PG8_BAR; PG8_WAIT_L(0); PG8_MMA(0, 1, At, B1); PG8_BAR;
            PG8_LDA(At, 0, 1); PG8_STAGE(PG8_SA(0, 0), a2, voffA);
            PG8_BAR; PG8_WAIT_L(0); PG8_MMA(1, 0, At, B0); PG8_BAR; PG8_SCHED;
            PG8_STAGE(PG8_SB(0, 1), b2 + hstep, voffB);
            PG8_WAIT_V(6); PG8_BAR; PG8_MMA(1, 1, At, B1); PG8_BAR;
            PG8_LDB(B0, 1, 0); PG8_SCHED; PG8_LDA(At, 1, 0); PG8_STAGE(PG8_SA(0, 1), a2 + hstep, voffA);
            PG8_WAIT_L(8); PG8_BAR; PG8_WAIT_L(0); PG8_MMA(0, 0, At, B0); PG8_BAR; PG8_SCHED;
            PG8_LDB(B1, 1, 1); PG8_STAGE(PG8_SB(1, 0), b3, voffB);
            PG8_BAR; PG8_WAIT_L(0); PG8_MMA(0, 1, At, B1); PG8_BAR;
            PG8_LDA(At, 1, 1); PG8_STAGE(PG8_SA(1, 0), a3, voffA);
            PG8_BAR; PG8_WAIT_L(0); PG8_MMA(1, 0, At, B0); PG8_BAR; PG8_SCHED;
            PG8_STAGE(PG8_SB(1, 1), b3 + hstep, voffB);
            PG8_WAIT_V(6); PG8_BAR; PG8_MMA(1, 1, At, B1); PG8_BAR;
            }
        }
        if constexpr (ALIGN_EPI) { if (wr == 0) PG8_BAR; }
        if constexpr (!Epi::AFTER_DRAIN) { E(acc, cur, wr, wc, fr, fq); S.done(cur); }
        if (!has_next) break;
#pragma unroll
        for (int a = 0; a < 2; ++a)
#pragma unroll
            for (int b = 0; b < 2; ++b)
#pragma unroll
                for (int m = 0; m < 4; ++m)
#pragma unroll
                    for (int n = 0; n < 2; ++n) acc[a][b][m][n] = (f32x4){0.f, 0.f, 0.f, 0.f};
        cur = nxt; cA = nA; cB = nB; ++ui;
        if constexpr (ALIGN_EPI) { if (wr == 1) PG8_BAR; }
    }
    PG8_WAIT_V(0);
    if constexpr (!ALIGN_EPI) { if (wr == 0) PG8_BAR; }
    PG8_BAR;
    if constexpr (Epi::AFTER_DRAIN) { E.fused(acc, cur, wr, wc, fr, fq, lds, wid, lane); S.done(cur); }
#undef PG8_SA
#undef PG8_SB
#undef PG8_STAGE
#undef PG8_LDA
#undef PG8_LDB
#undef PG8_MMA
#undef PG8_WAIT_V
#undef PG8_WAIT_L
#undef PG8_BAR
#undef PG8_SCHED
}
}

constexpr int DM = 1024, NSEQ_P = 16, TP = 2048, NSEQ_S = 32, TS = 32, PAST = 2048;
constexpr int MROWS = NSEQ_P * TP + NSEQ_S * TS;
constexpr int NH = 4, INCOLS = 2560, DFF = 4096, CW = 31, CPAD = 30, WB = 512;
constexpr float EPS = 1e-6f, LAM_INIT = 0.2f;
constexpr float LOG2E = 1.4426950408889634f;
constexpr size_t O_YP = 0, O_YS = (size_t)NSEQ_P * TP * DM, O_KP = O_YS + (size_t)NSEQ_S * TS * DM, O_VP = O_KP + (size_t)NSEQ_P * TP * 512,
                 O_CP = O_VP + (size_t)NSEQ_P * TP * 512, O_KS = O_CP + (size_t)NSEQ_P * CPAD * WB, O_VS = O_KS + (size_t)NSEQ_S * TS * 512,
                 O_CS = O_VS + (size_t)NSEQ_S * TS * 512, O_END = O_CS + (size_t)NSEQ_S * CPAD * WB;
static_assert(O_END == 69943296, "output size");
constexpr size_t MiB = 1u << 20;
constexpr size_t WS_CTL = 0, CTL_ZERO_BYTES = 1 * MiB;
constexpr size_t WS_WIN = 2 * MiB, WS_WOUT = 7 * MiB, WS_WUP = 9 * MiB, WS_WDN = 17 * MiB;
constexpr size_t WS_XN = 26 * MiB;
constexpr size_t WS_H = 92 * MiB;
constexpr size_t WS_Q = 92 * MiB, WS_KP = 125 * MiB, WS_VP = 157 * MiB, WS_KC = 189 * MiB, WS_VC = 255 * MiB, WS_U = 321 * MiB, WS_AC = 354 * MiB, WS_END = 420 * MiB;
static_assert(WS_XN + (size_t)MROWS * DM * 2 <= WS_H && WS_H + (size_t)MROWS * DFF * 2 <= WS_END && WS_KC + (size_t)NSEQ_S * pg8::KC_ROWS * 512 * 2 <= WS_VC && WS_VC + (size_t)NSEQ_S * pg8::KC_ROWS * 512 * 2 <= WS_U && WS_U + (size_t)MROWS * 512 * 2 <= WS_AC && WS_AC + (size_t)MROWS * DM * 2 <= WS_END, "ws map");
constexpr int CW_TMO = 0, CW_CODE = 1, CW_BAR = 4096;

constexpr int RING_OFF = 0, RING_BYTES = 131072;
constexpr int LDSCTL_OFF = RING_BYTES, MISC_OFF = LDSCTL_OFF + 320;
constexpr int LDS_BYTES = 147456;
constexpr int NWAVES = 8;

#define GAS __attribute__((address_space(1)))
#define LAS __attribute__((address_space(3)))
typedef unsigned short bf16;
typedef unsigned v4u __attribute__((ext_vector_type(4)));
typedef float f32x4 __attribute__((ext_vector_type(4)));
typedef float f32x16 __attribute__((ext_vector_type(16)));
typedef short bf16x8 __attribute__((ext_vector_type(8)));
typedef short s16x4 __attribute__((ext_vector_type(4)));
typedef GAS unsigned gu32;
#define RLX_AGENT __ATOMIC_RELAXED, __HIP_MEMORY_SCOPE_AGENT
#define LDS_WAIT() asm volatile("s_waitcnt lgkmcnt(0)" ::: "memory")
#define VM_WAIT() asm volatile("s_waitcnt vmcnt(0)" ::: "memory")
__device__ __forceinline__ unsigned f2bf(float f) { unsigned u = __builtin_bit_cast(unsigned, f); return (u + 0x7fffu + ((u >> 16) & 1u)) >> 16; }
__device__ __forceinline__ unsigned pk2(float lo, float hi) { return f2bf(lo) | (f2bf(hi) << 16); }
__device__ __forceinline__ float bf2f(unsigned short h) { return __builtin_bit_cast(float, (unsigned)h << 16); }

namespace att {
constexpr int SLOTK = 16384, SLOTV = 16384;
constexpr int L_K = 0, L_V = 2 * SLOTK, L_WS = L_V + 2 * SLOTV, L_TAB = L_WS + 2048, L_END = L_TAB + 4 * 192 * 4;
static_assert(L_END <= RING_BYTES, "attention LDS");
__device__ __forceinline__ int crow(int r, int hi) { return (r & 3) + 8 * (r >> 2) + 4 * hi; }
typedef float f32x2_t __attribute__((ext_vector_type(2))); typedef __bf16 bf16x2_t __attribute__((ext_vector_type(2)));
__device__ __forceinline__ unsigned cvtpk_s(float lo, float hi) { f32x2_t v = {lo, hi}; bf16x2_t b = __builtin_convertvector(v, bf16x2_t); return __builtin_bit_cast(unsigned, b); }
typedef short v4i16_t __attribute__((ext_vector_type(4)));
__device__ __forceinline__ s16x4 vtr(const LAS unsigned char* p) { return __builtin_bit_cast(s16x4, __builtin_amdgcn_ds_read_tr16_b64_v4i16((LAS v4i16_t*)p)); }
__device__ __forceinline__ void glds(const bf16* g, LAS unsigned char* l) { __builtin_amdgcn_global_load_lds((const unsigned*)g, (LAS unsigned*)l, 16, 0, 0); }
__device__ __forceinline__ int t5_bucket(int delta) {
    int n = -delta, ret = 0; if (n < 0) { ret = 16; n = -n; }
    const int v = n < 8 ? n : (n < 12 ? 8 : n < 16 ? 9 : n < 23 ? 10 : n < 32 ? 11 : n < 46 ? 12 : n < 64 ? 13 : n < 91 ? 14 : 15);
    return ret + v;
}
struct AUnit { const bf16* Q; const bf16* K; const bf16* V; bf16* O; int h, NT, nkeys, qpos0, nrb; };

__device__ __forceinline__ void attn_unit(const AUnit& u, LAS unsigned char* lds, float lam, const float* __restrict__ subg) {
    const int tid = threadIdx.x, lane = tid & 63, r32 = lane & 31, hi = lane >> 5;
    const int wid = __builtin_amdgcn_readfirstlane(tid >> 6), mp = wid & 1, rb = wid >> 1;
    const bool active = rb < u.nrb;
    const int qbase = u.qpos0 + 32 * rb, chunk = qbase >> 6;
    LAS float* wsf = (LAS float*)(lds + L_WS) + wid * 64;
    const LAS float* tab = (const LAS float*)(lds + L_TAB) + u.h * 192;
    const bf16* ksrc = u.K + (size_t)lane * 512 + u.h * 128 + wid * 8;
    const bf16* vsrc = u.V + (size_t)(16 * (wid & 3) + (lane >> 2)) * 512 + u.h * 128 + (wid >> 2) * 32 + (lane & 3) * 8;
#define ATT_DMA(t, slot) do { const size_t go_ = (size_t)(t) * 64 * 512; \
        glds(ksrc + go_, lds + L_K + (slot) * SLOTK + wid * 1024); glds(ksrc + go_ + 64, lds + L_K + (slot) * SLOTK + 8192 + wid * 1024); \
        glds(vsrc + go_, lds + L_V + (slot) * SLOTV + wid * 1024); glds(vsrc + go_ + 64, lds + L_V + (slot) * SLOTV + 8192 + wid * 1024); } while (0)
    bf16x8 qr[4];
#pragma unroll
    for (int d0 = 0; d0 < 4; ++d0) qr[d0] = active ? *(const bf16x8*)(u.Q + (size_t)(32 * rb + r32) * 512 + u.h * 128 + mp * 64 + d0 * 16 + hi * 8) : (bf16x8){0, 0, 0, 0, 0, 0, 0, 0};
    float m = -1e30f, l = 0.f; f32x16 o[4];
#pragma unroll
    for (int d = 0; d < 4; ++d) o[d] = f32x16{};
    ATT_DMA(0, 0);
    for (int t = 0; t < u.NT; ++t) {
        asm volatile("s_waitcnt vmcnt(0) lgkmcnt(0)\n\ts_barrier" ::: "memory");
        if (t + 1 < u.NT) ATT_DMA(t + 1, (t + 1) & 1);
        if (active && t <= chunk) {
            const int slot = t & 1;
            const LAS unsigned char* kb = lds + L_K + slot * SLOTK + mp * 8192 + hi * 1024 + r32 * 16;
            f32x16 p0 = f32x16{}, p1 = f32x16{};
#pragma unroll
            for (int d0 = 0; d0 < 4; ++d0) { const bf16x8 b0 = *(const LAS bf16x8*)(kb + d0 * 2048), b1 = *(const LAS bf16x8*)(kb + d0 * 2048 + 512);
                p0 = __builtin_amdgcn_mfma_f32_32x32x16_bf16(b0, qr[d0], p0, 0, 0, 0); p1 = __builtin_amdgcn_mfma_f32_32x32x16_bf16(b1, qr[d0], p1, 0, 0, 0); }
            const int kq = 64 * t - qbase;
            if (kq + 63 <= -128) { const float c = tab[0];
#pragma unroll
                for (int r = 0; r < 16; ++r) { p0[r] += c; p1[r] += c; } }
            else { const int dl = kq - r32 + 128;
#pragma unroll
                for (int r = 0; r < 16; ++r) { const int j = dl + crow(r, hi); const int i0 = min(max(j, 0), 191), i1 = min(max(j + 32, 0), 191); p0[r] += tab[i0]; p1[r] += tab[i1]; } }
            if (64 * t + 64 > u.nkeys) {
#pragma unroll
                for (int r = 0; r < 16; ++r) { const int j = 64 * t + crow(r, hi); if (j >= u.nkeys) p0[r] = -1e30f; if (j + 32 >= u.nkeys) p1[r] = -1e30f; } }
            float rm = fmaxf(p0[0], p1[0]);
#pragma unroll
            for (int r = 1; r < 16; ++r) rm = fmaxf(rm, fmaxf(p0[r], p1[r]));
            { auto rr = __builtin_amdgcn_permlane32_swap(__float_as_uint(rm), __float_as_uint(rm), false, false); rm = fmaxf(__uint_as_float(rr[0]), __uint_as_float(rr[1])); }
            const float mn = fmaxf(m, rm), alpha = __builtin_amdgcn_exp2f(m - mn); m = mn;
            float rs = 0.f;
#pragma unroll
            for (int r = 0; r < 16; ++r) { p0[r] = __builtin_amdgcn_exp2f(p0[r] - mn); p1[r] = __builtin_amdgcn_exp2f(p1[r] - mn); rs += p0[r] + p1[r]; }
            l = l * alpha + rs;
            if (__builtin_amdgcn_ballot_w64(alpha != 1.0f) != 0ull) {
                if (hi == 0) wsf[r32] = alpha;
#pragma unroll
                for (int r = 0; r < 16; ++r) { const float a = wsf[crow(r, hi)];
#pragma unroll
                    for (int d = 0; d < 4; ++d) o[d][r] *= a; }
            }
            v4u pw[4];
#pragma unroll
            for (int i = 0; i < 4; ++i) { pw[0][i] = cvtpk_s(p0[2 * i], p0[2 * i + 1]); pw[1][i] = cvtpk_s(p0[8 + 2 * i], p0[9 + 2 * i]); pw[2][i] = cvtpk_s(p1[2 * i], p1[2 * i + 1]); pw[3][i] = cvtpk_s(p1[8 + 2 * i], p1[9 + 2 * i]); }
            const LAS unsigned char* vp = lds + L_V + slot * SLOTV + ((lane >> 4) & 1) * 32 + (lane & 3) * 8 + (4 * hi + ((lane & 15) >> 2)) * 64;
#pragma unroll
            for (int d = 0; d < 4; ++d)
#pragma unroll
                for (int ks = 0; ks < 4; ++ks) { const s16x4 lo = vtr(vp + d * 4096 + ks * 1024), h4 = vtr(vp + d * 4096 + ks * 1024 + 512);
                    const bf16x8 vf = (bf16x8){lo[0], lo[1], lo[2], lo[3], h4[0], h4[1], h4[2], h4[3]};
                    o[d] = __builtin_amdgcn_mfma_f32_32x32x16_bf16(__builtin_bit_cast(bf16x8, pw[ks]), vf, o[d], 0, 0, 0); }
        }
    }
#undef ATT_DMA
    __syncthreads();
    { auto rr = __builtin_amdgcn_permlane32_swap(__float_as_uint(l), __float_as_uint(l), false, false); l = __uint_as_float(rr[0]) + __uint_as_float(rr[1]); }
    if (active) {
        if (hi == 0) wsf[r32] = 1.0f / l;
#pragma unroll
        for (int r = 0; r < 16; ++r) { const float a = wsf[crow(r, hi)];
#pragma unroll
            for (int d = 0; d < 4; ++d) o[d][r] *= a; }
        if (mp == 1) { LAS float* X = (LAS float*)lds + rb * 4096;
#pragma unroll
            for (int d = 0; d < 4; ++d)
#pragma unroll
                for (int r = 0; r < 16; ++r) X[(d * 16 + r) * 64 + lane] = o[d][r]; }
    }
    __syncthreads();
    if (active && mp == 0) {
        const LAS float* X = (const LAS float*)lds + rb * 4096;
        float ss[16];
#pragma unroll
        for (int r = 0; r < 16; ++r) ss[r] = 0.f;
#pragma unroll
        for (int d = 0; d < 4; ++d)
#pragma unroll
            for (int r = 0; r < 16; ++r) { const float a = o[d][r] - lam * X[(d * 16 + r) * 64 + lane]; o[d][r] = a; ss[r] += a * a; }
#pragma unroll
        for (int off = 1; off < 32; off <<= 1)
#pragma unroll
            for (int r = 0; r < 16; ++r) ss[r] += __shfl_xor(ss[r], off);
        float g[4];
#pragma unroll
        for (int d = 0; d < 4; ++d) g[d] = subg[32 * d + r32] * (1.0f - LAM_INIT);
#pragma unroll
        for (int r = 0; r < 16; ++r) { const float rstd = 1.0f / sqrtf(ss[r] * (1.0f / 128.0f) + EPS); bf16* op = u.O + (size_t)(32 * rb + crow(r, hi)) * 1024 + u.h * 128 + r32;
#pragma unroll
            for (int d = 0; d < 4; ++d) op[32 * d] = (bf16)f2bf(o[d][r] * rstd * g[d]); }
    }
    __syncthreads();
}
}
#define XB_TMO      128
#define XB_XCNT(j)  (256  + 64 * (j))
#define XB_XSUB(j)  (1280 + 64 * (j))
#define XB_XGEN(j)  (2304 + 64 * (j))
#define XB_TOP      3328
#define XB_TOPGEN   3392
#define XCD_BAR_WORDS 3456
#define XB_SPIN_CAP (1u << 18)

__device__ __forceinline__ unsigned xb_ld(unsigned* p)              { return __hip_atomic_load(p, __ATOMIC_RELAXED, __HIP_MEMORY_SCOPE_AGENT); }
__device__ __forceinline__ unsigned xb_add(unsigned* p, unsigned v) { return __hip_atomic_fetch_add(p, v, __ATOMIC_RELAXED, __HIP_MEMORY_SCOPE_AGENT); }
__device__ __forceinline__ unsigned xb_xcc_id() { return (unsigned)__builtin_amdgcn_s_getreg((3 << 11) | 20) & 0xFu; }
#define XB_SPIN(cond, bar) do { unsigned _sp = 0; while (cond) { __builtin_amdgcn_s_sleep(1); \
    if ((++_sp & 255u) == 0u) { if (xb_ld(&(bar)[XB_TMO])) break; if (_sp > XB_SPIN_CAP) { atomicAdd(&(bar)[XB_TMO], 1u); break; } } } } while (0)

struct XcdBarrier {
    unsigned* bar; unsigned x;
    volatile LAS unsigned* st;
};

__device__ __forceinline__ XcdBarrier xcd_barrier_post(unsigned* bar, volatile LAS unsigned* st) {
    XcdBarrier b; b.bar = bar; b.x = xb_xcc_id(); b.st = st;
    if (threadIdx.x == 0) (void)xb_add(&bar[XB_XCNT(b.x)], 1u);
    return b;
}
__device__ __forceinline__ void xcd_barrier_complete(unsigned* bar, unsigned x, unsigned& nloc, unsigned& nx) {
    const unsigned G = gridDim.x * gridDim.y * gridDim.z;
    unsigned sum, cnt, mine, sp = 0u;
    for (;;) {
        sum = 0u; cnt = 0u; mine = 0u;
#pragma unroll
        for (unsigned j = 0; j < 16; ++j) { const unsigned c = xb_ld(&bar[XB_XCNT(j)]); sum += c; cnt += (c > 0u) ? 1u : 0u; mine = (j == x) ? c : mine; }
        if (sum == G) break;
        __builtin_amdgcn_s_sleep(1);
        if ((++sp & 255u) == 0u) { if (xb_ld(&bar[XB_TMO])) break; if (sp > XB_SPIN_CAP) { atomicAdd(&bar[XB_TMO], 1u); break; } }
    }
    nloc = mine > 0u ? mine : 1u; nx = cnt > 0u ? cnt : 1u;
}

__device__ __forceinline__ void xcd_barrier(const XcdBarrier& b) {
    asm volatile("s_waitcnt vmcnt(0)" ::: "memory");
    __syncthreads();
    if (threadIdx.x == 0) {
        unsigned* bar = b.bar;
        __builtin_amdgcn_s_waitcnt(0);
        unsigned nloc = b.st[0], nx = b.st[1];
        if (nloc == 0u) { xcd_barrier_complete(bar, b.x, nloc, nx); b.st[0] = nloc; b.st[1] = nx; }
        const unsigned old = xb_add(&bar[XB_XSUB(b.x)], 1u);
        const unsigned gen = old / nloc;
        if (old + 1u == (gen + 1u) * nloc) {
            __builtin_amdgcn_fence(__ATOMIC_RELEASE, "agent");
            asm volatile("s_waitcnt vmcnt(0)" ::: "memory");
            const unsigned og = xb_add(&bar[XB_TOP], 1u);
            const unsigned tg = og / nx;
            if (og + 1u == (tg + 1u) * nx) xb_add(&bar[XB_TOPGEN], 1u);
            else XB_SPIN(xb_ld(&bar[XB_TOPGEN]) == tg, bar);
            __builtin_amdgcn_fence(__ATOMIC_ACQUIRE, "agent");
            xb_add(&bar[XB_XGEN(b.x)], 1u);
            asm volatile("s_waitcnt vmcnt(0)" ::: "memory");
        } else {
            XB_SPIN(xb_ld(&bar[XB_XGEN(b.x)]) == gen, bar);
            __builtin_amdgcn_fence(__ATOMIC_ACQUIRE, "agent");
            asm volatile("s_waitcnt vmcnt(0)" ::: "memory");
        }
    }
    __syncthreads();
}

struct Frame {
    LAS unsigned char* lds;
    volatile LAS unsigned* MISC;
    gu32* ctl;
    int tid, lane, wave;
    int vcu, G;
    const float *xp, *xs, *cache_k, *cache_v, *state_conv, *rel_bias, *ln1_g, *w_in, *lq1, *lk1, *lq2, *lk2, *subln_g, *w_dw, *b_dw, *cln_g, *cln_b, *w_out, *ln2_g, *w_up, *w_down, *lnf_g;
    float* out;
    bf16 *Win_t, *Wout_t, *Wup_t, *Wdn_t, *XN, *Q, *Kp, *Vp, *Kc, *Vc, *U, *AC, *H;
};
__device__ __forceinline__ float wave_sum(float v) {
#pragma unroll
    for (int o = 1; o < 64; o <<= 1) v += __shfl_xor(v, o);
    return v;
}
__device__ __forceinline__ void p0_transpose_item(const float* W, int K, int N, bf16* WT, LAS float* scr, int k0, int n0, int sn0, int lane) {
#pragma unroll 8
    for (int i = 0; i < 32; ++i) { const int kk = 2 * i + (lane >> 5); scr[kk * 33 + (lane & 31)] = W[(size_t)(k0 + kk) * N + sn0 + (lane & 31)]; }
    LDS_WAIT(); asm volatile("" ::: "memory");
    const int c = lane & 7;
#pragma unroll
    for (int j = 0; j < 4; ++j) { const int n = (lane >> 3) + 8 * j; const LAS float* s = scr + (8 * c) * 33 + n;
        v4u o; o.x = pk2(s[0 * 33], s[1 * 33]); o.y = pk2(s[2 * 33], s[3 * 33]); o.z = pk2(s[4 * 33], s[5 * 33]); o.w = pk2(s[6 * 33], s[7 * 33]);
        *(GAS v4u*)(WT + (size_t)(n0 + n) * K + k0 + 8 * c) = o; }
    LDS_WAIT(); asm volatile("" ::: "memory");
}
__device__ __forceinline__ int win_src_col(int n0) {
    if (n0 < 1536) return n0;
    const int j = n0 - 1536, t = j >> 8, jj = j & 255;
    return jj < 128 ? 1536 + 128 * t + jj : 2048 + 128 * t + (jj - 128);
}
template <bool BF> __device__ __forceinline__ void rms_row(const float* xrow, const float* g, void* orow, int lane) {
    const GAS f32x4* xr = (const GAS f32x4*)xrow + lane; const GAS f32x4* gr = (const GAS f32x4*)g + lane;
    f32x4 v[4]; float s = 0.f;
#pragma unroll
    for (int j = 0; j < 4; ++j) { v[j] = xr[64 * j]; s += (v[j].x * v[j].x + v[j].y * v[j].y) + (v[j].z * v[j].z + v[j].w * v[j].w); }
    const float rstd = 1.0f / sqrtf(wave_sum(s) * (1.0f / 1024.0f) + EPS);
#pragma unroll
    for (int j = 0; j < 4; ++j) { const f32x4 gg = gr[64 * j]; const f32x4 y = v[j] * rstd * gg;
        if (BF) ((GAS unsigned long long*)orow)[lane + 64 * j] = (unsigned long long)pk2(y.x, y.y) | ((unsigned long long)pk2(y.z, y.w) << 32);
        else ((GAS f32x4*)orow)[lane + 64 * j] = y; }
}
__device__ __forceinline__ const float* x_row(const Frame& F, int R) { return R < pg8::PROMPT_ROWS ? F.xp + (size_t)R * DM : F.xs + (size_t)(R - pg8::PROMPT_ROWS) * DM; }

__device__ __forceinline__ void p0_prologue(Frame& F) {
    LAS float* scr = (LAS float*)(F.lds + RING_OFF + F.wave * 16384);
    const int gw = F.vcu * NWAVES + F.wave, NGW = F.G * NWAVES;
    constexpr int I_IN = (DM / 64) * (INCOLS / 32), I_OUT = (DM / 64) * (DM / 32), I_UP = (DM / 64) * (DFF / 32), I_DN = (DFF / 64) * (DM / 32);
    constexpr int NITEMS = I_IN + I_OUT + I_UP + I_DN;
    for (int it = gw; it < NITEMS; it += NGW) {
        int r = it;
        if (r < I_IN) { const int nb = INCOLS / 32, kb = r / nb, n0 = 32 * (r % nb); p0_transpose_item(F.w_in, DM, INCOLS, F.Win_t, scr, 64 * kb, n0, win_src_col(n0), F.lane); continue; } r -= I_IN;
        if (r < I_OUT) { const int nb = DM / 32, kb = r / nb, n0 = 32 * (r % nb); p0_transpose_item(F.w_out, DM, DM, F.Wout_t, scr, 64 * kb, n0, n0, F.lane); continue; } r -= I_OUT;
        if (r < I_UP) { const int nb = DFF / 32, kb = r / nb, n0 = 32 * (r % nb); p0_transpose_item(F.w_up, DM, DFF, F.Wup_t, scr, 64 * kb, n0, n0, F.lane); continue; } r -= I_UP;
        { const int nb = DM / 32, kb = r / nb, n0 = 32 * (r % nb); p0_transpose_item(F.w_down, DFF, DM, F.Wdn_t, scr, 64 * kb, n0, n0, F.lane); }
    }
    for (int R = gw; R < MROWS; R += NGW) rms_row<true>(x_row(F, R), F.ln1_g, F.XN + (size_t)R * DM, F.lane);
    const int gt = (F.vcu * NWAVES + F.wave) * 64 + F.lane, NGT = NGW * 64;
    constexpr int GPB = PAST * 512 / 8;
    for (int g = gt; g < NSEQ_S * GPB; g += NGT) { const int b = g / GPB, w = g % GPB; const size_t so = (size_t)g * 8, dof = ((size_t)b * pg8::KC_ROWS * 512) + (size_t)w * 8;
        const f32x4 a0 = *(const GAS f32x4*)(F.cache_k + so), a1 = *(const GAS f32x4*)(F.cache_k + so + 4), b0 = *(const GAS f32x4*)(F.cache_v + so), b1 = *(const GAS f32x4*)(F.cache_v + so + 4);
        v4u ko, vo; ko.x = pk2(a0.x, a0.y); ko.y = pk2(a0.z, a0.w); ko.z = pk2(a1.x, a1.y); ko.w = pk2(a1.z, a1.w); vo.x = pk2(b0.x, b0.y); vo.y = pk2(b0.z, b0.w); vo.z = pk2(b1.x, b1.y); vo.w = pk2(b1.z, b1.w);
        *(GAS v4u*)(F.Kc + dof) = ko; *(GAS v4u*)(F.Vc + dof) = vo; }
    constexpr int ZPB = 32 * 512 / 8;
    for (int g = gt; g < NSEQ_S * ZPB; g += NGT) { const int b = g / ZPB, w = g % ZPB; const size_t dof = ((size_t)b * pg8::KC_ROWS + 2080) * 512 + (size_t)w * 8; const v4u z = {0u, 0u, 0u, 0u};
        *(GAS v4u*)(F.Kc + dof) = z; *(GAS v4u*)(F.Vc + dof) = z; }
}

__device__ __forceinline__ void attn_phase(Frame& F) {
    LAS float* tab = (LAS float*)(F.lds + att::L_TAB);
    for (int i = F.tid; i < 4 * 192; i += NWAVES * 64) { const int h = i / 192, d = i % 192 - 128; tab[i] = F.rel_bias[att::t5_bucket(d) * NH + h] * LOG2E; }
    float s1 = 0.f, s2 = 0.f;
    for (int i = 0; i < 64; ++i) { s1 += F.lq1[i] * F.lk1[i]; s2 += F.lq2[i] * F.lk2[i]; }
    const float lam = expf(s1) - expf(s2) + LAM_INIT;
    __syncthreads();
    for (int pg = F.vcu; pg < 256; pg += F.G) {
        const int bh = pg >> 2, s = pg & 3, b = bh >> 2, h = bh & 3;
        for (int i = 0; i < 4; ++i) { const int qb = (i == 0) ? 15 - s : (i == 1) ? 8 + s : (i == 2) ? 7 - s : s;
            att::AUnit u; u.Q = F.Q + (size_t)(b * TP + 128 * qb) * 512; u.K = F.Kp + (size_t)b * TP * 512; u.V = F.Vp + (size_t)b * TP * 512; u.O = F.AC + (size_t)(b * TP + 128 * qb) * 1024;
            u.h = h; u.NT = 2 * qb + 2; u.nkeys = 64 * u.NT; u.qpos0 = 128 * qb; u.nrb = 4;
            att::attn_unit(u, F.lds, lam, F.subln_g); }
    }
    for (int su = F.vcu; su < NSEQ_S * NH; su += F.G) {
        const int b = su >> 2, h = su & 3;
        att::AUnit u; u.Q = F.Q + (size_t)(pg8::PROMPT_ROWS + b * TS) * 512; u.K = F.Kc + (size_t)b * pg8::KC_ROWS * 512; u.V = F.Vc + (size_t)b * pg8::KC_ROWS * 512; u.O = F.AC + (size_t)(pg8::PROMPT_ROWS + b * TS) * 1024;
        u.h = h; u.NT = 33; u.nkeys = PAST + TS; u.qpos0 = PAST; u.nrb = 1;
        att::attn_unit(u, F.lds, lam, F.subln_g);
    }
}

__device__ __forceinline__ void conv_phase(Frame& F) {
    LAS float* red = (LAS float*)(F.lds + 96 * 1024);
    LAS float* stat = red + 256;
    const int c = F.tid;
    float w[CW];
#pragma unroll
    for (int j = 0; j < CW; ++j) w[j] = F.w_dw[j * WB + c];
    const float bdw = F.b_dw[c], lg = F.cln_g[c], lb = F.cln_b[c];
    constexpr int NU_P = NSEQ_P * (TP / 16), NU_S = NSEQ_S * (TS / 16);
    for (int un = F.vcu; un < NU_P + NU_S; un += F.G) {
        int b, t0, T, rowbase; const float* pre = nullptr; float* ost;
        if (un < NU_P) { b = un / (TP / 16); t0 = (un % (TP / 16)) * 16; T = TP; rowbase = b * TP; ost = F.out + O_CP + (size_t)b * CPAD * WB; }
        else { const int s = un - NU_P; b = s >> 1; t0 = (s & 1) * 16; T = TS; rowbase = pg8::PROMPT_ROWS + b * TS; pre = F.state_conv + (size_t)b * CPAD * WB; ost = F.out + O_CS + (size_t)b * CPAD * WB; }
        float uf[46];
#pragma unroll
        for (int i = 0; i < 46; ++i) { const int t = t0 - CPAD + i;
            if (t >= 0) uf[i] = bf2f(F.U[(size_t)(rowbase + t) * WB + c]);
            else uf[i] = pre ? pre[(size_t)(CPAD + t) * WB + c] : 0.f; }
        float y[16];
#pragma unroll
        for (int i = 0; i < 16; ++i) { float a = bdw;
#pragma unroll
            for (int j = 0; j < CW; ++j) a += w[j] * uf[i + j];
            y[i] = a; }
#pragma unroll
        for (int i = 0; i < 16; ++i) { const float s1 = wave_sum(y[i]), s2 = wave_sum(y[i] * y[i]); if (F.lane == 0) { red[(i * 8 + F.wave) * 2] = s1; red[(i * 8 + F.wave) * 2 + 1] = s2; } }
        __syncthreads();
        if (F.tid < 32) { const int i = F.tid >> 1, k = F.tid & 1; float a = 0.f;
#pragma unroll
            for (int ww = 0; ww < 8; ++ww) a += red[(i * 8 + ww) * 2 + k];
            stat[F.tid] = a; }
        __syncthreads();
#pragma unroll
        for (int i = 0; i < 16; ++i) { const float mean = stat[2 * i] * (1.0f / WB), var = fmaxf(stat[2 * i + 1] * (1.0f / WB) - mean * mean, 0.f), rstd = 1.0f / sqrtf(var + EPS);
            float v = (y[i] - mean) * rstd * lg + lb; v = v * pg8::sigmoidf_fast(v);
            F.AC[(size_t)(rowbase + t0 + i) * 1024 + 512 + c] = (bf16)f2bf(v);
            const int t = t0 + i; if (t >= T - CPAD) ost[(size_t)(t - (T - CPAD)) * WB + c] = uf[CPAD + i]; }
        __syncthreads();
    }
}

#ifndef MK_N_LAUNCHES
#define MK_N_LAUNCHES 1
#endif
constexpr int N_PHASES = 8;
constexpr int N_LAUNCHES = MK_N_LAUNCHES;
struct Args { const float* in[22]; float* out; unsigned char* ws; int ph_lo, ph_hi, li, pad; };
__global__ void __launch_bounds__(NWAVES * 64, 2) fwd_kernel(Args args) {
    extern __shared__ __attribute__((aligned(16))) unsigned char lds[];
    Frame F;
    F.lds = (LAS unsigned char*)lds;
    F.MISC = (volatile LAS unsigned*)(F.lds + MISC_OFF);
    F.tid = threadIdx.x; F.lane = F.tid & 63; F.wave = __builtin_amdgcn_readfirstlane(F.tid >> 6);
    F.G = gridDim.x; { const int bx = blockIdx.x; F.vcu = (F.G % 8 == 0) ? (bx % 8) * (F.G / 8) + bx / 8 : bx; }
    unsigned char* ws = args.ws;
    F.ctl = (gu32*)(ws + WS_CTL);
    F.xp = args.in[0]; F.xs = args.in[1]; F.cache_k = args.in[2]; F.cache_v = args.in[3]; F.state_conv = args.in[4]; F.rel_bias = args.in[5]; F.ln1_g = args.in[6]; F.w_in = args.in[7];
    F.lq1 = args.in[8]; F.lk1 = args.in[9]; F.lq2 = args.in[10]; F.lk2 = args.in[11]; F.subln_g = args.in[12]; F.w_dw = args.in[13]; F.b_dw = args.in[14]; F.cln_g = args.in[15]; F.cln_b = args.in[16];
    F.w_out = args.in[17]; F.ln2_g = args.in[18]; F.w_up = args.in[19]; F.w_down = args.in[20]; F.lnf_g = args.in[21]; F.out = args.out;
    F.Win_t = (bf16*)(ws + WS_WIN); F.Wout_t = (bf16*)(ws + WS_WOUT); F.Wup_t = (bf16*)(ws + WS_WUP); F.Wdn_t = (bf16*)(ws + WS_WDN); F.XN = (bf16*)(ws + WS_XN);
    F.Q = (bf16*)(ws + WS_Q); F.Kp = (bf16*)(ws + WS_KP); F.Vp = (bf16*)(ws + WS_VP); F.Kc = (bf16*)(ws + WS_KC); F.Vc = (bf16*)(ws + WS_VC); F.U = (bf16*)(ws + WS_U); F.AC = (bf16*)(ws + WS_AC); F.H = (bf16*)(ws + WS_H);
    for (int u = F.tid; u < (LDS_BYTES - LDSCTL_OFF) / 4; u += NWAVES * 64) ((LAS unsigned*)(F.lds + LDSCTL_OFF))[u] = 0u;
    __syncthreads();
    XcdBarrier bar; bar.bar = (unsigned*)(F.ctl + CW_BAR); bar.x = 0; bar.st = nullptr;
    if (N_LAUNCHES == 1) bar = xcd_barrier_post((unsigned*)(F.ctl + CW_BAR), F.MISC + 8);
    const int lo = args.ph_lo, hi = args.ph_hi;
#define IN(k) (lo <= (k) && (k) < hi)
#define SEAM(k) do { if (IN(k) && IN((k) + 1)) xcd_barrier(bar); } while (0)
    const float QSCALE = 0.125f * LOG2E;

    if (IN(0)) { p0_prologue(F); SEAM(0); }
    if (IN(1)) {
        pg8::Gemm g{F.XN, F.Win_t, MROWS, INCOLS, DM}; pg8::StaticOrder S; S.init(MROWS, INCOLS, F.G, (int)blockIdx.x);
        pg8::EpiProj E{F.Q, F.Kp, F.Vp, F.Kc, F.Vc, F.U, F.out + O_KP, F.out + O_VP, F.out + O_KS, F.out + O_VS, QSCALE};
        pg8::gemm_phase<pg8::EpiProj, pg8::StaticOrder, true, true>(F.lds + RING_OFF, g, S, E);
        SEAM(1);
    }
    if (IN(2)) { attn_phase(F); conv_phase(F); SEAM(2); }
    if (IN(3)) {
        pg8::Gemm g{F.AC, F.Wout_t, MROWS, DM, DM}; pg8::StaticOrder S; S.init(MROWS, DM, F.G, (int)blockIdx.x);
        pg8::EpiResF32 E{F.xp, F.xs, F.out};
        pg8::gemm_phase<pg8::EpiResF32, pg8::StaticOrder, true, true>(F.lds + RING_OFF, g, S, E);
        SEAM(3);
    }
    if (IN(4)) {
        const int gw = F.vcu * NWAVES + F.wave, NGW = F.G * NWAVES;
        for (int R = gw; R < MROWS; R += NGW) rms_row<true>(F.out + (size_t)R * DM, F.ln2_g, F.XN + (size_t)R * DM, F.lane);
        SEAM(4);
    }
    if (IN(5)) {
        pg8::Gemm g{F.XN, F.Wup_t, MROWS, DFF, DM}; pg8::StaticOrder S; S.init(MROWS, DFF, F.G, (int)blockIdx.x);
        pg8::EpiRelu2 E{F.H, DFF};
        pg8::gemm_phase<pg8::EpiRelu2, pg8::StaticOrder, true, true>(F.lds + RING_OFF, g, S, E);
        SEAM(5);
    }
    if (IN(6)) {
        pg8::Gemm g{F.H, F.Wdn_t, MROWS, DM, DFF}; pg8::StaticOrder S; S.init(MROWS, DM, F.G, (int)blockIdx.x);
        pg8::EpiResF32 E{F.out, F.out + (size_t)pg8::PROMPT_ROWS * DM, F.out};
        pg8::gemm_phase<pg8::EpiResF32, pg8::StaticOrder, true, true>(F.lds + RING_OFF, g, S, E);
        SEAM(6);
    }
    if (IN(7)) {
        const int gw = F.vcu * NWAVES + F.wave, NGW = F.G * NWAVES;
        for (int R = gw; R < MROWS; R += NGW) rms_row<false>(F.out + (size_t)R * DM, F.lnf_g, F.out + (size_t)R * DM, F.lane);
    }
#undef IN
#undef SEAM
}

extern "C" void kernel_launch(void* const* d_in, const int* in_sizes, int n_in, void* d_out, int out_size, void* d_ws, size_t ws_size, hipStream_t stream) {
    static int grid = 0;
    if (grid == 0) {
        if (n_in != 22 || (size_t)out_size != O_END || ws_size < WS_END) { fprintf(stderr, "kernel_launch: unexpected shapes: n_in %d out %d ws %zu; nothing launched\n", n_in, out_size, ws_size); grid = -1; return; }
        int dev = 0, cus = 0, per_cu = 0;
        if (hipGetDevice(&dev) != hipSuccess || hipDeviceGetAttribute(&cus, hipDeviceAttributeMultiprocessorCount, dev) != hipSuccess) { fprintf(stderr, "kernel_launch: device query failed\n"); grid = -1; return; }
        if (hipFuncSetAttribute((const void*)fwd_kernel, hipFuncAttributeMaxDynamicSharedMemorySize, LDS_BYTES) != hipSuccess) { fprintf(stderr, "kernel_launch: hipFuncSetAttribute failed\n"); grid = -1; return; }
        if (hipOccupancyMaxActiveBlocksPerMultiprocessor(&per_cu, (const void*)fwd_kernel, NWAVES * 64, LDS_BYTES) != hipSuccess || per_cu < 1) { fprintf(stderr, "kernel_launch: occupancy query reports %d blocks per CU\n", per_cu); }
        (void)hipGetLastError();
        grid = cus;
    }
    if (grid < 0) return;
    (void)hipMemsetAsync((char*)d_ws + WS_CTL, 0, CTL_ZERO_BYTES, stream);
    Args a{};
    for (int i = 0; i < 22; ++i) a.in[i] = (const float*)d_in[i];
    a.out = (float*)d_out; a.ws = (unsigned char*)d_ws;
    for (int li = 0; li < N_LAUNCHES; ++li) {
        a.ph_lo = (N_LAUNCHES == 1) ? 0 : li; a.ph_hi = (N_LAUNCHES == 1) ? N_PHASES : li + 1; a.li = li;
        hipLaunchKernelGGL(fwd_kernel, dim3(grid), dim3(NWAVES * 64), LDS_BYTES, stream, a);
    }
}
```

```cpp
#include <hip/hip_runtime.h>
#include <hip/hip_bf16.h>
#include <cstdio>
#include <cstdint>
#include <cmath>
namespace pg8 {
#define PG8_LAS __attribute__((address_space(3)))
typedef unsigned short bf16_t;
typedef short bf16x8 __attribute__((ext_vector_type(8)));
typedef float f32x4 __attribute__((ext_vector_type(4)));
typedef unsigned u32x4 __attribute__((ext_vector_type(4)));
constexpr int BM = 256, BK = 64, HALF = 128, HTB = HALF * BK * 2  , STAGE_BYTES = 8 * HTB, NXCD = 8, WGM = 8;

__host__ __device__ __forceinline__ int lds_byte(int r, int c) { const int st = (r >> 4) * 2 + (c >> 5), rr = r & 15, cc = c & 31, ob = rr * 64 + cc * 2; return st * 1024 + (ob ^ (((ob >> 9) & 1) << 5)); }
__host__ __device__ __forceinline__ void stage_rc(int b, int& R, int& C) { const int st = b / 1024, sb = b % 1024, swz = sb ^ (((sb >> 9) & 1) << 5); R = (st >> 1) * 16 + swz / 64; C = (st & 1) * 32 + (swz % 64) / 2; }
__host__ __device__ __forceinline__ int perm32(int rho) { const int n = rho >> 4, i = rho & 15; return 8 * (i >> 2) + 4 * n + (i & 3); }

struct Unit { int pm, pn; };
struct Gemm { const bf16_t* A; const bf16_t* Bt; int M, N, K; };

struct StaticOrder {
    int nM, nN, nwg, G, c;
    __host__ __device__ void init(int M, int N, int G_, int c_) { nM = M / BM; nN = N / BM; nwg = nM * nN; G = G_; c = c_; }
    __host__ __device__ bool next(int i, Unit& u) const {
        const long L = (long)i * G + c; if (L >= nwg) return false;
        int wgid = (int)L; { const int q = nwg / NXCD, r = nwg % NXCD, xcd = wgid % NXCD, off = wgid / NXCD; wgid = (xcd < r ? xcd * (q + 1) : r * (q + 1) + (xcd - r) * q) + off; }
        const int nig = WGM * nN, gid = wgid / nig, fm = gid * WGM, gsz = (nM - fm) < WGM ? (nM - fm) : WGM;
        u.pm = fm + ((wgid % nig) % gsz); u.pn = (wgid % nig) / gsz; return true;
    }
    __device__ __forceinline__ void a_ready(const Unit&) const {}
    __device__ __forceinline__ void done(const Unit&) const {}
};


__device__ __forceinline__ unsigned cvt_pk_bf16(float lo, float hi) { unsigned r; asm volatile("v_cvt_pk_bf16_f32 %0, %1, %2" : "=v"(r) : "v"(lo), "v"(hi)); return r; }
__device__ __forceinline__ u32x4 pack8(const f32x4 v0, const f32x4 v1) { u32x4 w; w.x = cvt_pk_bf16(v0[0], v0[1]); w.y = cvt_pk_bf16(v0[2], v0[3]); w.z = cvt_pk_bf16(v1[0], v1[1]); w.w = cvt_pk_bf16(v1[2], v1[3]); return w; }
__device__ __forceinline__ float sigmoidf_fast(float g) { return __builtin_amdgcn_rcpf(1.0f + __builtin_amdgcn_exp2f(-1.4426950408889634f * g)); }

constexpr int PROMPT_ROWS = 32768;
constexpr int KC_ROWS = 2112;

struct EpiProj {
    static constexpr bool PERM = true, AFTER_DRAIN = false;
    bf16_t *Q, *Kp, *Vp, *Kc, *Vc, *U; float *okp, *ovp, *oks, *ovs; float qscale;
    __device__ __forceinline__ void operator()(const f32x4 (&acc)[2][2][4][2], const Unit& u, int wr, int wc, int fr, int fq) const {
        const int pn = u.pn; const bool sample = u.pm >= PROMPT_ROWS / BM;
        const int row0 = u.pm * BM + wr * 64 + fr, cl = wc * 32 + 8 * fq;
        if (pn < 2) {
#pragma unroll
            for (int ai = 0; ai < 2; ++ai)
#pragma unroll
                for (int m = 0; m < 4; ++m) { bf16_t* rp = Q + (size_t)(row0 + ai * HALF + m * 16) * 512 + pn * 256 + cl;
#pragma unroll
                    for (int bj = 0; bj < 2; ++bj) *(u32x4*)(rp + bj * HALF) = pack8(acc[ai][bj][m][0] * qscale, acc[ai][bj][m][1] * qscale); }
        } else if (pn < 6) {
            const bool isV = pn >= 4; const int c0 = (pn & 1) * 256 + cl;
#pragma unroll
            for (int ai = 0; ai < 2; ++ai)
#pragma unroll
                for (int m = 0; m < 4; ++m) { const int R = row0 + ai * HALF + m * 16; bf16_t* bp; float* fp;
                    if (!sample) { bp = (isV ? Vp : Kp) + (size_t)R * 512 + c0; fp = (isV ? ovp : okp) + (size_t)R * 512 + c0; }
                    else { const int s = R - PROMPT_ROWS, b = s >> 5, t = s & 31; bp = (isV ? Vc : Kc) + (size_t)(b * KC_ROWS + 2048 + t) * 512 + c0; fp = (isV ? ovs : oks) + (size_t)s * 512 + c0; }
#pragma unroll
                    for (int bj = 0; bj < 2; ++bj) { const f32x4 v0 = acc[ai][bj][m][0], v1 = acc[ai][bj][m][1];
                        *(u32x4*)(bp + bj * HALF) = pack8(v0, v1); *(f32x4*)(fp + bj * HALF) = v0; *(f32x4*)(fp + bj * HALF + 4) = v1; } }
        } else {
            const int c0 = (pn - 6) * 128 + cl;
#pragma unroll
            for (int ai = 0; ai < 2; ++ai)
#pragma unroll
                for (int m = 0; m < 4; ++m) { const int R = row0 + ai * HALF + m * 16; f32x4 o0, o1;
#pragma unroll
                    for (int i = 0; i < 4; ++i) { o0[i] = acc[ai][0][m][0][i] * sigmoidf_fast(acc[ai][1][m][0][i]); o1[i] = acc[ai][0][m][1][i] * sigmoidf_fast(acc[ai][1][m][1][i]); }
                    *(u32x4*)(U + (size_t)R * 512 + c0) = pack8(o0, o1); }
        }
    }
};
struct EpiResF32 {
    static constexpr bool PERM = false, AFTER_DRAIN = false;
    const float* resP; const float* resS; float* out;
    __device__ __forceinline__ void operator()(const f32x4 (&acc)[2][2][4][2], const Unit& u, int wr, int wc, int fr, int fq) const {
        const int row0 = u.pm * BM + wr * 64 + fr, col0 = u.pn * BM + wc * 32 + 4 * fq;
        const float* rbase = (u.pm >= PROMPT_ROWS / BM) ? resS - (size_t)PROMPT_ROWS * 1024 : resP;
#pragma unroll
        for (int ai = 0; ai < 2; ++ai)
#pragma unroll
            for (int m = 0; m < 4; ++m) { const size_t off = (size_t)(row0 + ai * HALF + m * 16) * 1024 + col0;
#pragma unroll
                for (int bj = 0; bj < 2; ++bj)
#pragma unroll
                    for (int n = 0; n < 2; ++n) { const f32x4 r = *(const f32x4*)(rbase + off + bj * HALF + n * 16); *(f32x4*)(out + off + bj * HALF + n * 16) = r + acc[ai][bj][m][n]; } }
    }
};
struct EpiRelu2 {
    static constexpr bool PERM = true, AFTER_DRAIN = false;
    bf16_t* O; int ldc;
    __device__ __forceinline__ void operator()(const f32x4 (&acc)[2][2][4][2], const Unit& u, int wr, int wc, int fr, int fq) const {
        const int row0 = u.pm * BM + wr * 64 + fr, col0 = u.pn * BM + wc * 32 + 8 * fq;
#pragma unroll
        for (int ai = 0; ai < 2; ++ai)
#pragma unroll
            for (int m = 0; m < 4; ++m) { bf16_t* rp = O + (size_t)(row0 + ai * HALF + m * 16) * ldc + col0;
#pragma unroll
                for (int bj = 0; bj < 2; ++bj) { f32x4 v0 = acc[ai][bj][m][0], v1 = acc[ai][bj][m][1];
#pragma unroll
                    for (int i = 0; i < 4; ++i) { const float a = fmaxf(v0[i], 0.f), b = fmaxf(v1[i], 0.f); v0[i] = a * a; v1[i] = b * b; }
                    *(u32x4*)(rp + bj * HALF) = pack8(v0, v1); } }
    }
};

template <class Epi, class Sched, bool ALIGN_EPI = false, bool SP2 = false>
__device__ __forceinline__ void gemm_phase(PG8_LAS unsigned char* lds, const Gemm g, const Sched& S, const Epi& E) {
    const int tid = threadIdx.x, wid = __builtin_amdgcn_readfirstlane(tid >> 6), lane = tid & 63, wr = wid >> 2, wc = wid & 3, fr = lane & 15, fq = lane >> 4;
    const int K = g.K, nt = K / BK;
    unsigned voffA[2], voffB[2];
#pragma unroll
    for (int i = 0; i < 2; ++i) { int R, C; stage_rc(tid * 16 + i * 8192, R, C); const int Rb = Epi::PERM ? ((R & ~31) + perm32(R & 31)) : R;
        voffA[i] = (unsigned)(R * K + C) * 2u; voffB[i] = (unsigned)(Rb * K + C) * 2u; }
    const size_t kstep = (size_t)(BK * 2);
    const size_t hstep = (size_t)HALF * K * 2;
    const size_t tstep = 2 * hstep;
    const unsigned ldsw = (unsigned)wid * 1024u;
    const int aoff = lds_byte(wr * 64 + fr, fq * 8), boff = lds_byte(wc * 32 + fr, fq * 8);
#define PG8_SA(b, h) (((b) * 2 + (h)) * HTB)
#define PG8_SB(b, h) ((4 + (b) * 2 + (h)) * HTB)
#define PG8_STAGE(bufoff, gbase, voff) do { _Pragma("unroll") for (int _i = 0; _i < 2; ++_i) \
        __builtin_amdgcn_global_load_lds((const unsigned*)((const char*)(gbase) + (voff)[_i]), (PG8_LAS unsigned*)(lds + (bufoff) + ldsw + _i * 8192), 16, 0, 0); } while (0)
#define PG8_LDA(dst, b, h) do { _Pragma("unroll") for (int m = 0; m < 4; ++m) _Pragma("unroll") for (int k = 0; k < 2; ++k) dst[m][k] = *(const PG8_LAS bf16x8*)(lds + PG8_SA(b, h) + aoff + m * 2048 + k * 1024); } while (0)
#define PG8_LDB(dst, b, h) do { _Pragma("unroll") for (int n = 0; n < 2; ++n) _Pragma("unroll") for (int k = 0; k < 2; ++k) dst[n][k] = *(const PG8_LAS bf16x8*)(lds + PG8_SB(b, h) + boff + n * 2048 + k * 1024); } while (0)
#define PG8_MMA(ai, bj, At, Bt) do { __builtin_amdgcn_s_setprio(1); _Pragma("unroll") for (int m = 0; m < 4; ++m) _Pragma("unroll") for (int n = 0; n < 2; ++n) _Pragma("unroll") for (int k = 0; k < 2; ++k) \
        acc[ai][bj][m][n] = __builtin_amdgcn_mfma_f32_16x16x32_bf16(Bt[n][k], At[m][k], acc[ai][bj][m][n], 0, 0, 0); __builtin_amdgcn_s_setprio(0); } while (0)
#define PG8_WAIT_V(n) asm volatile("s_waitcnt vmcnt(" #n ")" ::: "memory")
#define PG8_WAIT_L(n) asm volatile("s_waitcnt lgkmcnt(" #n ")" ::: "memory")
#define PG8_BAR __builtin_amdgcn_s_barrier()
#define PG8_SCHED __builtin_amdgcn_sched_barrier(0)
    Unit cur, nxt; int ui = 0;
    if (!S.next(0, cur)) return;
    f32x4 acc[2][2][4][2];
#pragma unroll
    for (int a = 0; a < 2; ++a)
#pragma unroll
        for (int b = 0; b < 2; ++b)
#pragma unroll
            for (int m = 0; m < 4; ++m)
#pragma unroll
                for (int n = 0; n < 2; ++n) acc[a][b][m][n] = (f32x4){0.f, 0.f, 0.f, 0.f};
    bf16x8 At[4][2], B0[2][2], B1[2][2];
    const char* cA = (const char*)g.A + (size_t)cur.pm * tstep; const char* cB = (const char*)g.Bt + (size_t)cur.pn * tstep;
    S.a_ready(cur);
    if constexpr (SP2) {
        PG8_STAGE(PG8_SB(0, 0), cB, voffB); PG8_STAGE(PG8_SB(0, 1), cB + hstep, voffB); PG8_STAGE(PG8_SA(0, 0), cA, voffA); PG8_STAGE(PG8_SA(0, 1), cA + hstep, voffA);
        if (wr == 1) PG8_BAR;
        PG8_WAIT_V(2); PG8_BAR;
        PG8_STAGE(PG8_SB(1, 0), cB + kstep, voffB); PG8_STAGE(PG8_SA(1, 0), cA + kstep, voffA); PG8_STAGE(PG8_SB(1, 1), cB + hstep + kstep, voffB);
        PG8_WAIT_V(6); PG8_BAR;
    } else {
        PG8_STAGE(PG8_SB(0, 0), cB, voffB); PG8_STAGE(PG8_SA(0, 0), cA, voffA); PG8_STAGE(PG8_SB(0, 1), cB + hstep, voffB); PG8_STAGE(PG8_SA(0, 1), cA + hstep, voffA);
        if (wr == 1) PG8_BAR;
        PG8_WAIT_V(4); PG8_BAR;
        PG8_STAGE(PG8_SB(1, 0), cB + kstep, voffB); PG8_STAGE(PG8_SA(1, 0), cA + kstep, voffA); PG8_STAGE(PG8_SB(1, 1), cB + hstep + kstep, voffB);
        PG8_WAIT_V(6); PG8_BAR;
    }
    for (;;) {
        const bool has_next = S.next(ui + 1, nxt);
        const char* nA = has_next ? (const char*)g.A + (size_t)nxt.pm * tstep : cA; const char* nB = has_next ? (const char*)g.Bt + (size_t)nxt.pn * tstep : cB;
        for (int t = 0; t < nt; t += 2) {
            const bool last = (t == nt - 2);
            const char* a1 = cA + (size_t)(t + 1) * kstep;
            const char* a2 = last ? nA : cA + (size_t)(t + 2) * kstep; const char* b2 = last ? nB : cB + (size_t)(t + 2) * kstep;
            const char* a3 = a2 + kstep; const char* b3 = b2 + kstep;
            if (last && has_next) S.a_ready(nxt);
            if constexpr (SP2) {
            PG8_LDB(B0, 0, 0); PG8_LDB(B1, 0, 1); PG8_SCHED; PG8_LDA(At, 0, 0); PG8_STAGE(PG8_SA(1, 1), a1 + hstep, voffA);
            PG8_WAIT_V(8); PG8_WAIT_L(0); PG8_BAR; PG8_MMA(0, 0, At, B0); PG8_MMA(0, 1, At, B1); PG8_BAR; PG8_SCHED;
            PG8_LDA(At, 0, 1); PG8_STAGE(PG8_SB(0, 0), b2, voffB); PG8_STAGE(PG8_SB(0, 1), b2 + hstep, voffB); PG8_STAGE(PG8_SA(0, 0), a2, voffA);
            PG8_WAIT_V(8); PG8_WAIT_L(0); PG8_BAR; PG8_MMA(1, 0, At, B0); PG8_MMA(1, 1, At, B1); PG8_BAR; PG8_SCHED;
            PG8_LDB(B0, 1, 0); PG8_LDB(B1, 1, 1); PG8_SCHED; PG8_LDA(At, 1, 0); PG8_STAGE(PG8_SA(0, 1), a2 + hstep, voffA);
            PG8_WAIT_V(8); PG8_WAIT_L(0); PG8_BAR; PG8_MMA(0, 0, At, B0); PG8_MMA(0, 1, At, B1); PG8_BAR; PG8_SCHED;
            PG8_LDA(At, 1, 1); PG8_STAGE(PG8_SB(1, 0), b3, voffB); PG8_STAGE(PG8_SB(1, 1), b3 + hstep, voffB); PG8_STAGE(PG8_SA(1, 0), a3, voffA);
            PG8_WAIT_V(8); PG8_WAIT_L(0); PG8_BAR; PG8_MMA(1, 0, At, B0); PG8_MMA(1, 1, At, B1); PG8_BAR; PG8_SCHED;
            } else {
            PG8_LDB(B0, 0, 0); PG8_SCHED; PG8_LDA(At, 0, 0); PG8_STAGE(PG8_SA(1, 1), a1 + hstep, voffA);
            PG8_WAIT_L(8); PG8_BAR; PG8_WAIT_L(0); PG8_MMA(0, 0, At, B0); PG8_BAR; PG8_SCHED;
            PG8_LDB(B1, 0, 1); PG8_STAGE(PG8_SB(0, 0), b2, voffB);
            PG8_BAR; PG8_WAIT_L(0); PG8_MMA(0, 1, At, B1); PG8_BAR;
            PG8_LDA(At, 0, 1); PG8_STAGE(PG8_SA(0, 0), a2, voffA);
            PG8_BAR; PG8_WAIT_L(0); PG8_MMA(1, 0, At, B0); PG8_BAR; PG8_SCHED;
            PG8_STAGE(PG8_SB(0, 1), b2 + hstep, voffB);
            PG8_WAIT_V(6); PG8_BAR; PG8_MMA(1, 1, At, B1); PG8_BAR;
            PG8_LDB(B0, 1, 0); PG8_SCHED; PG8_LDA(At, 1, 0); PG8_STAGE(PG8_SA(0, 1), a2 + hstep, voffA);
            PG8_WAIT_L(8); PG8_BAR; PG8_WAIT_L(0); PG8_MMA(0, 0, At, B0); PG8_BAR; PG8_SCHED;
            PG8_LDB(B1, 1, 1); PG8_STAGE(PG8_SB(1, 0), b3, voffB);
            PG8_BAR; PG8_WAIT_L(0); PG8_MMA(0, 1, At, B1); PG8_BAR;
            PG8_LDA(At, 1, 1); PG8_STAGE(PG8_SA(1, 0), a3, voffA);
            PG8_BAR; PG8_WAIT_L(0); PG8_MMA(1, 0, At, B0); PG8_BAR; PG8_SCHED;
            PG8_STAGE(PG8_SB(1, 1), b3 + hstep, voffB);
            PG8_WAIT_V(6); PG8_BAR; PG8_MMA(1, 1, At, B1); PG8_BAR;
            }
        }
        if constexpr (ALIGN_EPI) { if (wr == 0) PG8_BAR; }
        if constexpr (!Epi::AFTER_DRAIN) { E(acc, cur, wr, wc, fr, fq); S.done(cur); }
        if (!has_next) break;
#pragma unroll
        for (int a = 0; a < 2; ++a)
#pragma unroll
            for (int b = 0; b < 2; ++b)
#pragma unroll
                for (int m = 0; m < 4; ++m)
#pragma unroll
                    for (int n = 0; n < 2; ++n) acc[a][b][m][n] = (f32x4){0.f, 0.f, 0.f, 0.f};
        cur = nxt; cA = nA; cB = nB; ++ui;
        if constexpr (ALIGN_EPI) { if (wr == 1) PG8_BAR; }
    }
    PG8_WAIT_V(0);
    if constexpr (!ALIGN_EPI) { if (wr == 0) PG8_BAR; }
    PG8_BAR;
    if constexpr (Epi::AFTER_DRAIN) { E.fused(acc, cur, wr, wc, fr, fq, lds, wid, lane); S.done(cur); }
#undef PG8_SA
#undef PG8_SB
#undef PG8_STAGE
#undef PG8_LDA
#undef PG8_LDB
#undef PG8_MMA
#undef PG8_WAIT_V
#undef PG8_WAIT_L
#undef PG8_BAR
#undef PG8_SCHED
}
}

constexpr int DM = 1024, NSEQ_P = 16, TP = 2048, NSEQ_S = 32, TS = 32, PAST = 2048;
constexpr int MROWS = NSEQ_P * TP + NSEQ_S * TS;
constexpr int NH = 4, INCOLS = 2560, DFF = 4096, CW = 31, CPAD = 30, WB = 512;
constexpr float EPS = 1e-6f, LAM_INIT = 0.2f;
constexpr float LOG2E = 1.4426950408889634f;
constexpr size_t O_YP = 0, O_YS = (size_t)NSEQ_P * TP * DM, O_KP = O_YS + (size_t)NSEQ_S * TS * DM, O_VP = O_KP + (size_t)NSEQ_P * TP * 512,
                 O_CP = O_VP + (size_t)NSEQ_P * TP * 512, O_KS = O_CP + (size_t)NSEQ_P * CPAD * WB, O_VS = O_KS + (size_t)NSEQ_S * TS * 512,
                 O_CS = O_VS + (size_t)NSEQ_S * TS * 512, O_END = O_CS + (size_t)NSEQ_S * CPAD * WB;
static_assert(O_END == 69943296, "output size");
constexpr size_t MiB = 1u << 20;
constexpr size_t WS_CTL = 0, CTL_ZERO_BYTES = 1 * MiB;
constexpr size_t WS_WIN = 2 * MiB, WS_WOUT = 7 * MiB, WS_WUP = 9 * MiB, WS_WDN = 17 * MiB;
constexpr size_t WS_XN = 26 * MiB;
constexpr size_t WS_H = 92 * MiB;
constexpr size_t WS_Q = 92 * MiB, WS_KP = 125 * MiB, WS_VP = 157 * MiB, WS_KC = 189 * MiB, WS_VC = 255 * MiB, WS_U = 321 * MiB, WS_AC = 354 * MiB, WS_END = 420 * MiB;
static_assert(WS_XN + (size_t)MROWS * DM * 2 <= WS_H && WS_H + (size_t)MROWS * DFF * 2 <= WS_END && WS_KC + (size_t)NSEQ_S * pg8::KC_ROWS * 512 * 2 <= WS_VC && WS_VC + (size_t)NSEQ_S * pg8::KC_ROWS * 512 * 2 <= WS_U && WS_U + (size_t)MROWS * 512 * 2 <= WS_AC && WS_AC + (size_t)MROWS * DM * 2 <= WS_END, "ws map");
constexpr int CW_TMO = 0, CW_CODE = 1, CW_BAR = 4096;

constexpr int RING_OFF = 0, RING_BYTES = 131072;
constexpr int LDSCTL_OFF = RING_BYTES, MISC_OFF = LDSCTL_OFF + 320;
constexpr int LDS_BYTES = 147456;
constexpr int NWAVES = 8;

#define GAS __attribute__((address_space(1)))
#define LAS __attribute__((address_space(3)))
typedef unsigned short bf16;
typedef unsigned v4u __attribute__((ext_vector_type(4)));
typedef float f32x4 __attribute__((ext_vector_type(4)));
typedef float f32x16 __attribute__((ext_vector_type(16)));
typedef short bf16x8 __attribute__((ext_vector_type(8)));
typedef short s16x4 __attribute__((ext_vector_type(4)));
typedef GAS unsigned gu32;
#define RLX_AGENT __ATOMIC_RELAXED, __HIP_MEMORY_SCOPE_AGENT
#define LDS_WAIT() asm volatile("s_waitcnt lgkmcnt(0)" ::: "memory")
#define VM_WAIT() asm volatile("s_waitcnt vmcnt(0)" ::: "memory")
__device__ __forceinline__ unsigned f2bf(float f) { unsigned u = __builtin_bit_cast(unsigned, f); return (u + 0x7fffu + ((u >> 16) & 1u)) >> 16; }
__device__ __forceinline__ unsigned pk2(float lo, float hi) { return f2bf(lo) | (f2bf(hi) << 16); }
__device__ __forceinline__ float bf2f(unsigned short h) { return __builtin_bit_cast(float, (unsigned)h << 16); }

namespace att {
constexpr int SLOTK = 16384, SLOTV = 16384;
constexpr int L_K = 0, L_V = 2 * SLOTK, L_WS = L_V + 2 * SLOTV, L_TAB = L_WS + 2048, L_END = L_TAB + 4 * 192 * 4;
static_assert(L_END <= RING_BYTES, "attention LDS");
__device__ __forceinline__ int crow(int r, int hi) { return (r & 3) + 8 * (r >> 2) + 4 * hi; }
typedef float f32x2_t __attribute__((ext_vector_type(2))); typedef __bf16 bf16x2_t __attribute__((ext_vector_type(2)));
__device__ __forceinline__ unsigned cvtpk_s(float lo, float hi) { f32x2_t v = {lo, hi}; bf16x2_t b = __builtin_convertvector(v, bf16x2_t); return __builtin_bit_cast(unsigned, b); }
typedef short v4i16_t __attribute__((ext_vector_type(4)));
__device__ __forceinline__ s16x4 vtr(const LAS unsigned char* p) { return __builtin_bit_cast(s16x4, __builtin_amdgcn_ds_read_tr16_b64_v4i16((LAS v4i16_t*)p)); }
__device__ __forceinline__ void glds(const bf16* g, LAS unsigned char* l) { __builtin_amdgcn_global_load_lds((const unsigned*)g, (LAS unsigned*)l, 16, 0, 0); }
__device__ __forceinline__ int t5_bucket(int delta) {
    int n = -delta, ret = 0; if (n < 0) { ret = 16; n = -n; }
    const int v = n < 8 ? n : (n < 12 ? 8 : n < 16 ? 9 : n < 23 ? 10 : n < 32 ? 11 : n < 46 ? 12 : n < 64 ? 13 : n < 91 ? 14 : 15);
    return ret + v;
}
struct AUnit { const bf16* Q; const bf16* K; const bf16* V; bf16* O; int h, NT, nkeys, qpos0, nrb; };

__device__ __forceinline__ void attn_unit(const AUnit& u, LAS unsigned char* lds, float lam, const float* __restrict__ subg) {
    const int tid = threadIdx.x, lane = tid & 63, r32 = lane & 31, hi = lane >> 5;
    const int wid = __builtin_amdgcn_readfirstlane(tid >> 6), mp = wid & 1, rb = wid >> 1;
    const bool active = rb < u.nrb;
    const int qbase = u.qpos0 + 32 * rb, chunk = qbase >> 6;
    LAS float* wsf = (LAS float*)(lds + L_WS) + wid * 64;
    const LAS float* tab = (const LAS float*)(lds + L_TAB) + u.h * 192;
    const bf16* ksrc = u.K + (size_t)lane * 512 + u.h * 128 + wid * 8;
    const bf16* vsrc = u.V + (size_t)(16 * (wid & 3) + (lane >> 2)) * 512 + u.h * 128 + (wid >> 2) * 32 + (lane & 3) * 8;
#define ATT_DMA(t, slot) do { const size_t go_ = (size_t)(t) * 64 * 512; \
        glds(ksrc + go_, lds + L_K + (slot) * SLOTK + wid * 1024); glds(ksrc + go_ + 64, lds + L_K + (slot) * SLOTK + 8192 + wid * 1024); \
        glds(vsrc + go_, lds + L_V + (slot) * SLOTV + wid * 1024); glds(vsrc + go_ + 64, lds + L_V + (slot) * SLOTV + 8192 + wid * 1024); } while (0)
    bf16x8 qr[4];
#pragma unroll
    for (int d0 = 0; d0 < 4; ++d0) qr[d0] = active ? *(const bf16x8*)(u.Q + (size_t)(32 * rb + r32) * 512 + u.h * 128 + mp * 64 + d0 * 16 + hi * 8) : (bf16x8){0, 0, 0, 0, 0, 0, 0, 0};
    float m = -1e30f, l = 0.f; f32x16 o[4];
#pragma unroll
    for (int d = 0; d < 4; ++d) o[d] = f32x16{};
    ATT_DMA(0, 0);
    for (int t = 0; t < u.NT; ++t) {
        asm volatile("s_waitcnt vmcnt(0) lgkmcnt(0)\n\ts_barrier" ::: "memory");
        if (t + 1 < u.NT) ATT_DMA(t + 1, (t + 1) & 1);
        if (active && t <= chunk) {
            const int slot = t & 1;
            const LAS unsigned char* kb = lds + L_K + slot * SLOTK + mp * 8192 + hi * 1024 + r32 * 16;
            f32x16 p0 = f32x16{}, p1 = f32x16{};
#pragma unroll
            for (int d0 = 0; d0 < 4; ++d0) { const bf16x8 b0 = *(const LAS bf16x8*)(kb + d0 * 2048), b1 = *(const LAS bf16x8*)(kb + d0 * 2048 + 512);
                p0 = __builtin_amdgcn_mfma_f32_32x32x16_bf16(b0, qr[d0], p0, 0, 0, 0); p1 = __builtin_amdgcn_mfma_f32_32x32x16_bf16(b1, qr[d0], p1, 0, 0, 0); }
            const int kq = 64 * t - qbase;
            if (kq + 63 <= -128) { const float c = tab[0];
#pragma unroll
                for (int r = 0; r < 16; ++r) { p0[r] += c; p1[r] += c; } }
            else { const int dl = kq - r32 + 128;
#pragma unroll
                for (int r = 0; r < 16; ++r) { const int j = dl + crow(r, hi); const int i0 = min(max(j, 0), 191), i1 = min(max(j + 32, 0), 191); p0[r] += tab[i0]; p1[r] += tab[i1]; } }
            if (64 * t + 64 > u.nkeys) {
#pragma unroll
                for (int r = 0; r < 16; ++r) { const int j = 64 * t + crow(r, hi); if (j >= u.nkeys) p0[r] = -1e30f; if (j + 32 >= u.nkeys) p1[r] = -1e30f; } }
            float rm = fmaxf(p0[0], p1[0]);
#pragma unroll
            for (int r = 1; r < 16; ++r) rm = fmaxf(rm, fmaxf(p0[r], p1[r]));
            { auto rr = __builtin_amdgcn_permlane32_swap(__float_as_uint(rm), __float_as_uint(rm), false, false); rm = fmaxf(__uint_as_float(rr[0]), __uint_as_float(rr[1])); }
            const float mn = fmaxf(m, rm), alpha = __builtin_amdgcn_exp2f(m - mn); m = mn;
            float rs = 0.f;
#pragma unroll
            for (int r = 0; r < 16; ++r) { p0[r] = __builtin_amdgcn_exp2f(p0[r] - mn); p1[r] = __builtin_amdgcn_exp2f(p1[r] - mn); rs += p0[r] + p1[r]; }
            l = l * alpha + rs;
            if (__builtin_amdgcn_ballot_w64(alpha != 1.0f) != 0ull) {
                if (hi == 0) wsf[r32] = alpha;
#pragma unroll
                for (int r = 0; r < 16; ++r) { const float a = wsf[crow(r, hi)];
#pragma unroll
                    for (int d = 0; d < 4; ++d) o[d][r] *= a; }
            }
            v4u pw[4];
#pragma unroll
            for (int i = 0; i < 4; ++i) { pw[0][i] = cvtpk_s(p0[2 * i], p0[2 * i + 1]); pw[1][i] = cvtpk_s(p0[8 + 2 * i], p0[9 + 2 * i]); pw[2][i] = cvtpk_s(p1[2 * i], p1[2 * i + 1]); pw[3][i] = cvtpk_s(p1[8 + 2 * i], p1[9 + 2 * i]); }
            const LAS unsigned char* vp = lds + L_V + slot * SLOTV + ((lane >> 4) & 1) * 32 + (lane & 3) * 8 + (4 * hi + ((lane & 15) >> 2)) * 64;
#pragma unroll
            for (int d = 0; d < 4; ++d)
#pragma unroll
                for (int ks = 0; ks < 4; ++ks) { const s16x4 lo = vtr(vp + d * 4096 + ks * 1024), h4 = vtr(vp + d * 4096 + ks * 1024 + 512);
                    const bf16x8 vf = (bf16x8){lo[0], lo[1], lo[2], lo[3], h4[0], h4[1], h4[2], h4[3]};
                    o[d] = __builtin_amdgcn_mfma_f32_32x32x16_bf16(__builtin_bit_cast(bf16x8, pw[ks]), vf, o[d], 0, 0, 0); }
        }
    }
#undef ATT_DMA
    __syncthreads();
    { auto rr = __builtin_amdgcn_permlane32_swap(__float_as_uint(l), __float_as_uint(l), false, false); l = __uint_as_float(rr[0]) + __uint_as_float(rr[1]); }
    if (active) {
        if (hi == 0) wsf[r32] = 1.0f / l;
#pragma unroll
        for (int r = 0; r < 16; ++r) { const float a = wsf[crow(r, hi)];
#pragma unroll
            for (int d = 0; d < 4; ++d) o[d][r] *= a; }
        if (mp == 1) { LAS float* X = (LAS float*)lds + rb * 4096;
#pragma unroll
            for (int d = 0; d < 4; ++d)
#pragma unroll
                for (int r = 0; r < 16; ++r) X[(d * 16 + r) * 64 + lane] = o[d][r]; }
    }
    __syncthreads();
    if (active && mp == 0) {
        const LAS float* X = (const LAS float*)lds + rb * 4096;
        float ss[16];
#pragma unroll
        for (int r = 0; r < 16; ++r) ss[r] = 0.f;
#pragma unroll
        for (int d = 0; d < 4; ++d)
#pragma unroll
            for (int r = 0; r < 16; ++r) { const float a = o[d][r] - lam * X[(d * 16 + r) * 64 + lane]; o[d][r] = a; ss[r] += a * a; }
#pragma unroll
        for (int off = 1; off < 32; off <<= 1)
#pragma unroll
            for (int r = 0; r < 16; ++r) ss[r] += __shfl_xor(ss[r], off);
        float g[4];
#pragma unroll
        for (int d = 0; d < 4; ++d) g[d] = subg[32 * d + r32] * (1.0f - LAM_INIT);
#pragma unroll
        for (int r = 0; r < 16; ++r) { const float rstd = 1.0f / sqrtf(ss[r] * (1.0f / 128.0f) + EPS); bf16* op = u.O + (size_t)(32 * rb + crow(r, hi)) * 1024 + u.h * 128 + r32;
#pragma unroll
            for (int d = 0; d < 4; ++d) op[32 * d] = (bf16)f2bf(o[d][r] * rstd * g[d]); }
    }
    __syncthreads();
}
}
#define XB_TMO      128
#define XB_XCNT(j)  (256  + 64 * (j))
#define XB_XSUB(j)  (1280 + 64 * (j))
#define XB_XGEN(j)  (2304 + 64 * (j))
#define XB_TOP      3328
#define XB_TOPGEN   3392
#define XCD_BAR_WORDS 3456
#define XB_SPIN_CAP (1u << 18)

__device__ __forceinline__ unsigned xb_ld(unsigned* p)              { return __hip_atomic_load(p, __ATOMIC_RELAXED, __HIP_MEMORY_SCOPE_AGENT); }
__device__ __forceinline__ unsigned xb_add(unsigned* p, unsigned v) { return __hip_atomic_fetch_add(p, v, __ATOMIC_RELAXED, __HIP_MEMORY_SCOPE_AGENT); }
__device__ __forceinline__ unsigned xb_xcc_id() { return (unsigned)__builtin_amdgcn_s_getreg((3 << 11) | 20) & 0xFu; }
#define XB_SPIN(cond, bar) do { unsigned _sp = 0; while (cond) { __builtin_amdgcn_s_sleep(1); \
    if ((++_sp & 255u) == 0u) { if (xb_ld(&(bar)[XB_TMO])) break; if (_sp > XB_SPIN_CAP) { atomicAdd(&(bar)[XB_TMO], 1u); break; } } } } while (0)

struct XcdBarrier {
    unsigned* bar; unsigned x;
    volatile LAS unsigned* st;
};

__device__ __forceinline__ XcdBarrier xcd_barrier_post(unsigned* bar, volatile LAS unsigned* st) {
    XcdBarrier b; b.bar = bar; b.x = xb_xcc_id(); b.st = st;
    if (threadIdx.x == 0) (void)xb_add(&bar[XB_XCNT(b.x)], 1u);
    return b;
}
__device__ __forceinline__ void xcd_barrier_complete(unsigned* bar, unsigned x, unsigned& nloc, unsigned& nx) {
    const unsigned G = gridDim.x * gridDim.y * gridDim.z;
    unsigned sum, cnt, mine, sp = 0u;
    for (;;) {
        sum = 0u; cnt = 0u; mine = 0u;
#pragma unroll
        for (unsigned j = 0; j < 16; ++j) { const unsigned c = xb_ld(&bar[XB_XCNT(j)]); sum += c; cnt += (c > 0u) ? 1u : 0u; mine = (j == x) ? c : mine; }
        if (sum == G) break;
        __builtin_amdgcn_s_sleep(1);
        if ((++sp & 255u) == 0u) { if (xb_ld(&bar[XB_TMO])) break; if (sp > XB_SPIN_CAP) { atomicAdd(&bar[XB_TMO], 1u); break; } }
    }
    nloc = mine > 0u ? mine : 1u; nx = cnt > 0u ? cnt : 1u;
}

__device__ __forceinline__ void xcd_barrier(const XcdBarrier& b) {
    asm volatile("s_waitcnt vmcnt(0)" ::: "memory");
    __syncthreads();
    if (threadIdx.x == 0) {
        unsigned* bar = b.bar;
        __builtin_amdgcn_s_waitcnt(0);
        unsigned nloc = b.st[0], nx = b.st[1];
        if (nloc == 0u) { xcd_barrier_complete(bar, b.x, nloc, nx); b.st[0] = nloc; b.st[1] = nx; }
        const unsigned old = xb_add(&bar[XB_XSUB(b.x)], 1u);
        const unsigned gen = old / nloc;
        if (old + 1u == (gen + 1u) * nloc) {
            __builtin_amdgcn_fence(__ATOMIC_RELEASE, "agent");
            asm volatile("s_waitcnt vmcnt(0)" ::: "memory");
            const unsigned og = xb_add(&bar[XB_TOP], 1u);
            const unsigned tg = og / nx;
            if (og + 1u == (tg + 1u) * nx) xb_add(&bar[XB_TOPGEN], 1u);
            else XB_SPIN(xb_ld(&bar[XB_TOPGEN]) == tg, bar);
            __builtin_amdgcn_fence(__ATOMIC_ACQUIRE, "agent");
            xb_add(&bar[XB_XGEN(b.x)], 1u);
            asm volatile("s_waitcnt vmcnt(0)" ::: "memory");
        } else {
            XB_SPIN(xb_ld(&bar[XB_XGEN(b.x)]) == gen, bar);
            __builtin_amdgcn_fence(__ATOMIC_ACQUIRE, "agent");
            asm volatile("s_waitcnt vmcnt(0)" ::: "memory");
        }
    }
    __syncthreads();
}

struct Frame {
    LAS unsigned char* lds;
    volatile LAS unsigned* MISC;
    gu32* ctl;
    int tid, lane, wave;
    int vcu, G;
    const float *xp, *xs, *cache_k, *cache_v, *state_conv, *rel_bias, *ln1_g, *w_in, *lq1, *lk1, *lq2, *lk2, *subln_g, *w_dw, *b_dw, *cln_g, *cln_b, *w_out, *ln2_g, *w_up, *w_down, *lnf_g;
    float* out;
    bf16 *Win_t, *Wout_t, *Wup_t, *Wdn_t, *XN, *Q, *Kp, *Vp, *Kc, *Vc, *U, *AC, *H;
};
__device__ __forceinline__ float wave_sum(float v) {
#pragma unroll
    for (int o = 1; o < 64; o <<= 1) v += __shfl_xor(v, o);
    return v;
}
__device__ __forceinline__ void p0_transpose_item(const float* W, int K, int N, bf16* WT, LAS float* scr, int k0, int n0, int sn0, int lane) {
#pragma unroll 8
    for (int i = 0; i < 32; ++i) { const int kk = 2 * i + (lane >> 5); scr[kk * 33 + (lane & 31)] = W[(size_t)(k0 + kk) * N + sn0 + (lane & 31)]; }
    LDS_WAIT(); asm volatile("" ::: "memory");
    const int c = lane & 7;
#pragma unroll
    for (int j = 0; j < 4; ++j) { const int n = (lane >> 3) + 8 * j; const LAS float* s = scr + (8 * c) * 33 + n;
        v4u o; o.x = pk2(s[0 * 33], s[1 * 33]); o.y = pk2(s[2 * 33], s[3 * 33]); o.z = pk2(s[4 * 33], s[5 * 33]); o.w = pk2(s[6 * 33], s[7 * 33]);
        *(GAS v4u*)(WT + (size_t)(n0 + n) * K + k0 + 8 * c) = o; }
    LDS_WAIT(); asm volatile("" ::: "memory");
}
__device__ __forceinline__ int win_src_col(int n0) {
    if (n0 < 1536) return n0;
    const int j = n0 - 1536, t = j >> 8, jj = j & 255;
    return jj < 128 ? 1536 + 128 * t + jj : 2048 + 128 * t + (jj - 128);
}
template <bool BF> __device__ __forceinline__ void rms_row(const float* xrow, const float* g, void* orow, int lane) {
    const GAS f32x4* xr = (const GAS f32x4*)xrow + lane; const GAS f32x4* gr = (const GAS f32x4*)g + lane;
    f32x4 v[4]; float s = 0.f;
#pragma unroll
    for (int j = 0; j < 4; ++j) { v[j] = xr[64 * j]; s += (v[j].x * v[j].x + v[j].y * v[j].y) + (v[j].z * v[j].z + v[j].w * v[j].w); }
    const float rstd = 1.0f / sqrtf(wave_sum(s) * (1.0f / 1024.0f) + EPS);
#pragma unroll
    for (int j = 0; j < 4; ++j) { const f32x4 gg = gr[64 * j]; const f32x4 y = v[j] * rstd * gg;
        if (BF) ((GAS unsigned long long*)orow)[lane + 64 * j] = (unsigned long long)pk2(y.x, y.y) | ((unsigned long long)pk2(y.z, y.w) << 32);
        else ((GAS f32x4*)orow)[lane + 64 * j] = y; }
}
__device__ __forceinline__ const float* x_row(const Frame& F, int R) { return R < pg8::PROMPT_ROWS ? F.xp + (size_t)R * DM : F.xs + (size_t)(R - pg8::PROMPT_ROWS) * DM; }

__device__ __forceinline__ void p0_prologue(Frame& F) {
    LAS float* scr = (LAS float*)(F.lds + RING_OFF + F.wave * 16384);
    const int gw = F.vcu * NWAVES + F.wave, NGW = F.G * NWAVES;
    constexpr int I_IN = (DM / 64) * (INCOLS / 32), I_OUT = (DM / 64) * (DM / 32), I_UP = (DM / 64) * (DFF / 32), I_DN = (DFF / 64) * (DM / 32);
    constexpr int NITEMS = I_IN + I_OUT + I_UP + I_DN;
    for (int it = gw; it < NITEMS; it += NGW) {
        int r = it;
        if (r < I_IN) { const int nb = INCOLS / 32, kb = r / nb, n0 = 32 * (r % nb); p0_transpose_item(F.w_in, DM, INCOLS, F.Win_t, scr, 64 * kb, n0, win_src_col(n0), F.lane); continue; } r -= I_IN;
        if (r < I_OUT) { const int nb = DM / 32, kb = r / nb, n0 = 32 * (r % nb); p0_transpose_item(F.w_out, DM, DM, F.Wout_t, scr, 64 * kb, n0, n0, F.lane); continue; } r -= I_OUT;
        if (r < I_UP) { const int nb = DFF / 32, kb = r / nb, n0 = 32 * (r % nb); p0_transpose_item(F.w_up, DM, DFF, F.Wup_t, scr, 64 * kb, n0, n0, F.lane); continue; } r -= I_UP;
        { const int nb = DM / 32, kb = r / nb, n0 = 32 * (r % nb); p0_transpose_item(F.w_down, DFF, DM, F.Wdn_t, scr, 64 * kb, n0, n0, F.lane); }
    }
    for (int R = gw; R < MROWS; R += NGW) rms_row<true>(x_row(F, R), F.ln1_g, F.XN + (size_t)R * DM, F.lane);
    const int gt = (F.vcu * NWAVES + F.wave) * 64 + F.lane, NGT = NGW * 64;
    constexpr int GPB = PAST * 512 / 8;
    for (int g = gt; g < NSEQ_S * GPB; g += NGT) { const int b = g / GPB, w = g % GPB; const size_t so = (size_t)g * 8, dof = ((size_t)b * pg8::KC_ROWS * 512) + (size_t)w * 8;
        const f32x4 a0 = *(const GAS f32x4*)(F.cache_k + so), a1 = *(const GAS f32x4*)(F.cache_k + so + 4), b0 = *(const GAS f32x4*)(F.cache_v + so), b1 = *(const GAS f32x4*)(F.cache_v + so + 4);
        v4u ko, vo; ko.x = pk2(a0.x, a0.y); ko.y = pk2(a0.z, a0.w); ko.z = pk2(a1.x, a1.y); ko.w = pk2(a1.z, a1.w); vo.x = pk2(b0.x, b0.y); vo.y = pk2(b0.z, b0.w); vo.z = pk2(b1.x, b1.y); vo.w = pk2(b1.z, b1.w);
        *(GAS v4u*)(F.Kc + dof) = ko; *(GAS v4u*)(F.Vc + dof) = vo; }
    constexpr int ZPB = 32 * 512 / 8;
    for (int g = gt; g < NSEQ_S * ZPB; g += NGT) { const int b = g / ZPB, w = g % ZPB; const size_t dof = ((size_t)b * pg8::KC_ROWS + 2080) * 512 + (size_t)w * 8; const v4u z = {0u, 0u, 0u, 0u};
        *(GAS v4u*)(F.Kc + dof) = z; *(GAS v4u*)(F.Vc + dof) = z; }
}

__device__ __forceinline__ void attn_phase(Frame& F) {
    LAS float* tab = (LAS float*)(F.lds + att::L_TAB);
    for (int i = F.tid; i < 4 * 192; i += NWAVES * 64) { const int h = i / 192, d = i % 192 - 128; tab[i] = F.rel_bias[att::t5_bucket(d) * NH + h] * LOG2E; }
    float s1 = 0.f, s2 = 0.f;
    for (int i = 0; i < 64; ++i) { s1 += F.lq1[i] * F.lk1[i]; s2 += F.lq2[i] * F.lk2[i]; }
    const float lam = expf(s1) - expf(s2) + LAM_INIT;
    __syncthreads();
    for (int pg = F.vcu; pg < 256; pg += F.G) {
        const int bh = pg >> 2, s = pg & 3, b = bh >> 2, h = bh & 3;
        for (int i = 0; i < 4; ++i) { const int qb = (i == 0) ? 15 - s : (i == 1) ? 8 + s : (i == 2) ? 7 - s : s;
            att::AUnit u; u.Q = F.Q + (size_t)(b * TP + 128 * qb) * 512; u.K = F.Kp + (size_t)b * TP * 512; u.V = F.Vp + (size_t)b * TP * 512; u.O = F.AC + (size_t)(b * TP + 128 * qb) * 1024;
            u.h = h; u.NT = 2 * qb + 2; u.nkeys = 64 * u.NT; u.qpos0 = 128 * qb; u.nrb = 4;
            att::attn_unit(u, F.lds, lam, F.subln_g); }
    }
    for (int su = F.vcu; su < NSEQ_S * NH; su += F.G) {
        const int b = su >> 2, h = su & 3;
        att::AUnit u; u.Q = F.Q + (size_t)(pg8::PROMPT_ROWS + b * TS) * 512; u.K = F.Kc + (size_t)b * pg8::KC_ROWS * 512; u.V = F.Vc + (size_t)b * pg8::KC_ROWS * 512; u.O = F.AC + (size_t)(pg8::PROMPT_ROWS + b * TS) * 1024;
        u.h = h; u.NT = 33; u.nkeys = PAST + TS; u.qpos0 = PAST; u.nrb = 1;
        att::attn_unit(u, F.lds, lam, F.subln_g);
    }
}

__device__ __forceinline__ float dpp_row_sum(float v) {
    v += __builtin_bit_cast(float, __builtin_amdgcn_update_dpp(0, __builtin_bit_cast(int, v), 0xB1, 0xF, 0xF, true));
    v += __builtin_bit_cast(float, __builtin_amdgcn_update_dpp(0, __builtin_bit_cast(int, v), 0x4E, 0xF, 0xF, true));
    v += __builtin_bit_cast(float, __builtin_amdgcn_update_dpp(0, __builtin_bit_cast(int, v), 0x141, 0xF, 0xF, true));
    v += __builtin_bit_cast(float, __builtin_amdgcn_update_dpp(0, __builtin_bit_cast(int, v), 0x140, 0xF, 0xF, true));
    return v;
}
__device__ __forceinline__ float dpp_wave_sum63(float v) {
    v = dpp_row_sum(v);
    v += __builtin_bit_cast(float, __builtin_amdgcn_update_dpp(0, __builtin_bit_cast(int, v), 0x142, 0xA, 0xF, false));
    v += __builtin_bit_cast(float, __builtin_amdgcn_update_dpp(0, __builtin_bit_cast(int, v), 0x143, 0xC, 0xF, false));
    return v;
}
template <int NPRE, bool HP> __device__ __forceinline__ void conv_load(float (&u0)[38], float (&u1)[38], const bf16* up, const float* pp) {
#pragma unroll
    for (int i = 0; i < 38; ++i) {
        if (i >= NPRE) { const unsigned v = *(const unsigned*)(up + (size_t)i * WB); u0[i] = __builtin_bit_cast(float, v << 16); u1[i] = __builtin_bit_cast(float, v & 0xffff0000u); }
        else if (HP) { const float2 v = *(const float2*)(pp + (size_t)i * WB); u0[i] = v.x; u1[i] = v.y; }
        else { u0[i] = 0.f; u1[i] = 0.f; } }
}
__device__ __forceinline__ void conv_phase(Frame& F) {
    LAS float* red = (LAS float*)(F.lds + 96 * 1024);
    LAS float* stat = red + 128;
    const int cp = F.tid & 255, rh = F.wave >> 2, c = 2 * cp;
    float w0[CW], w1[CW];
#pragma unroll
    for (int j = 0; j < CW; ++j) { const float2 ww = *(const float2*)(F.w_dw + j * WB + c); w0[j] = ww.x; w1[j] = ww.y; }
    const float2 bdw = *(const float2*)(F.b_dw + c), lg = *(const float2*)(F.cln_g + c), lb = *(const float2*)(F.cln_b + c);
    constexpr int NU_P = NSEQ_P * (TP / 16), NU_S = NSEQ_S * (TS / 16);
    for (int un = F.vcu; un < NU_P + NU_S; un += F.G) {
        int b, t0, T, rowbase; const float* pre = nullptr; float* ost;
        if (un < NU_P) { b = un / (TP / 16); t0 = (un % (TP / 16)) * 16; T = TP; rowbase = b * TP; ost = F.out + O_CP + (size_t)b * CPAD * WB; }
        else { const int s = un - NU_P; b = s >> 1; t0 = (s & 1) * 16; T = TS; rowbase = pg8::PROMPT_ROWS + b * TS; pre = F.state_conv + (size_t)b * CPAD * WB; ost = F.out + O_CS + (size_t)b * CPAD * WB; }
        const int tb = t0 + 8 * rh;
        float u0[38], u1[38];
        { const int npre = tb >= CPAD ? 0 : CPAD - tb;
            const bf16* up = F.U + (size_t)(rowbase + tb - CPAD) * WB + c; const float* pp = pre ? pre + (size_t)tb * WB + c : nullptr;
            if (npre == 0) conv_load<0, false>(u0, u1, up, pp);
            else if (pre) { if (npre == 30) conv_load<30, true>(u0, u1, up, pp); else if (npre == 22) conv_load<22, true>(u0, u1, up, pp); else if (npre == 14) conv_load<14, true>(u0, u1, up, pp); else conv_load<6, true>(u0, u1, up, pp); }
            else { if (npre == 30) conv_load<30, false>(u0, u1, up, pp); else if (npre == 22) conv_load<22, false>(u0, u1, up, pp); else if (npre == 14) conv_load<14, false>(u0, u1, up, pp); else conv_load<6, false>(u0, u1, up, pp); } }
        float y0[8], y1[8];
#pragma unroll
        for (int i = 0; i < 8; ++i) { float a0 = bdw.x, a1 = bdw.y;
#pragma unroll
            for (int j = 0; j < CW; ++j) { a0 += w0[j] * u0[i + j]; a1 += w1[j] * u1[i + j]; }
            y0[i] = a0; y1[i] = a1; }
#pragma unroll
        for (int i = 0; i < 8; ++i) { const float s1 = dpp_wave_sum63(y0[i] + y1[i]), s2 = dpp_wave_sum63(y0[i] * y0[i] + y1[i] * y1[i]);
            if (F.lane == 63) { red[F.wave * 16 + 2 * i] = s1; red[F.wave * 16 + 2 * i + 1] = s2; } }
        __syncthreads();
        if (F.tid < 16) { const int r = F.tid, h = r >> 3, i = r & 7; float a = 0.f, q = 0.f;
#pragma unroll
            for (int ww = 0; ww < 4; ++ww) { a += red[(4 * h + ww) * 16 + 2 * i]; q += red[(4 * h + ww) * 16 + 2 * i + 1]; }
            const float mean = a * (1.0f / WB), var = fmaxf(q * (1.0f / WB) - mean * mean, 0.f);
            stat[2 * r] = mean; stat[2 * r + 1] = 1.0f / sqrtf(var + EPS); }
        __syncthreads();
#pragma unroll
        for (int i = 0; i < 8; ++i) { const float mean = stat[2 * (8 * rh + i)], rstd = stat[2 * (8 * rh + i) + 1];
            float v0 = (y0[i] - mean) * rstd * lg.x + lb.x, v1 = (y1[i] - mean) * rstd * lg.y + lb.y; v0 = v0 * pg8::sigmoidf_fast(v0); v1 = v1 * pg8::sigmoidf_fast(v1);
            *(unsigned*)(F.AC + (size_t)(rowbase + tb + i) * 1024 + 512 + c) = pk2(v0, v1);
            const int t = tb + i; if (t >= T - CPAD) *(float2*)(ost + (size_t)(t - (T - CPAD)) * WB + c) = make_float2(u0[CPAD + i], u1[CPAD + i]); }
        __syncthreads();
    }
}

#ifndef MK_N_LAUNCHES
#define MK_N_LAUNCHES 1
#endif
constexpr int N_PHASES = 8;
constexpr int N_LAUNCHES = MK_N_LAUNCHES;
struct Args { const float* in[22]; float* out; unsigned char* ws; int ph_lo, ph_hi, li, pad; };
__global__ void __launch_bounds__(NWAVES * 64, 2) fwd_kernel(Args args) {
    extern __shared__ __attribute__((aligned(16))) unsigned char lds[];
    Frame F;
    F.lds = (LAS unsigned char*)lds;
    F.MISC = (volatile LAS unsigned*)(F.lds + MISC_OFF);
    F.tid = threadIdx.x; F.lane = F.tid & 63; F.wave = __builtin_amdgcn_readfirstlane(F.tid >> 6);
    F.G = gridDim.x; { const int bx = blockIdx.x; F.vcu = (F.G % 8 == 0) ? (bx % 8) * (F.G / 8) + bx / 8 : bx; }
    unsigned char* ws = args.ws;
    F.ctl = (gu32*)(ws + WS_CTL);
    F.xp = args.in[0]; F.xs = args.in[1]; F.cache_k = args.in[2]; F.cache_v = args.in[3]; F.state_conv = args.in[4]; F.rel_bias = args.in[5]; F.ln1_g = args.in[6]; F.w_in = args.in[7];
    F.lq1 = args.in[8]; F.lk1 = args.in[9]; F.lq2 = args.in[10]; F.lk2 = args.in[11]; F.subln_g = args.in[12]; F.w_dw = args.in[13]; F.b_dw = args.in[14]; F.cln_g = args.in[15]; F.cln_b = args.in[16];
    F.w_out = args.in[17]; F.ln2_g = args.in[18]; F.w_up = args.in[19]; F.w_down = args.in[20]; F.lnf_g = args.in[21]; F.out = args.out;
    F.Win_t = (bf16*)(ws + WS_WIN); F.Wout_t = (bf16*)(ws + WS_WOUT); F.Wup_t = (bf16*)(ws + WS_WUP); F.Wdn_t = (bf16*)(ws + WS_WDN); F.XN = (bf16*)(ws + WS_XN);
    F.Q = (bf16*)(ws + WS_Q); F.Kp = (bf16*)(ws + WS_KP); F.Vp = (bf16*)(ws + WS_VP); F.Kc = (bf16*)(ws + WS_KC); F.Vc = (bf16*)(ws + WS_VC); F.U = (bf16*)(ws + WS_U); F.AC = (bf16*)(ws + WS_AC); F.H = (bf16*)(ws + WS_H);
    for (int u = F.tid; u < (LDS_BYTES - LDSCTL_OFF) / 4; u += NWAVES * 64) ((LAS unsigned*)(F.lds + LDSCTL_OFF))[u] = 0u;
    __syncthreads();
    XcdBarrier bar; bar.bar = (unsigned*)(F.ctl + CW_BAR); bar.x = 0; bar.st = nullptr;
    if (N_LAUNCHES == 1) bar = xcd_barrier_post((unsigned*)(F.ctl + CW_BAR), F.MISC + 8);
    const int lo = args.ph_lo, hi = args.ph_hi;
#define IN(k) (lo <= (k) && (k) < hi)
#define SEAM(k) do { if (IN(k) && IN((k) + 1)) xcd_barrier(bar); } while (0)
#ifndef REP_PHASE
#define REP_PHASE -1
#endif
#ifndef REP_N
#define REP_N 1
#endif
#define NREP(k) (((k) == REP_PHASE) ? 1 + REP_N : 1)
    const float QSCALE = 0.125f * LOG2E;

    if (IN(0)) for (int rep = 0; rep < NREP(0); ++rep) { p0_prologue(F); SEAM(0); }
    if (IN(1)) for (int rep = 0; rep < NREP(1); ++rep) {
        pg8::Gemm g{F.XN, F.Win_t, MROWS, INCOLS, DM}; pg8::StaticOrder S; S.init(MROWS, INCOLS, F.G, (int)blockIdx.x);
        pg8::EpiProj E{F.Q, F.Kp, F.Vp, F.Kc, F.Vc, F.U, F.out + O_KP, F.out + O_VP, F.out + O_KS, F.out + O_VS, QSCALE};
        pg8::gemm_phase<pg8::EpiProj, pg8::StaticOrder, true, true>(F.lds + RING_OFF, g, S, E);
        SEAM(1);
    }
    if (IN(2)) { for (int rep = 0; rep < NREP(2); ++rep) attn_phase(F); for (int rep = 0; rep < NREP(8); ++rep) conv_phase(F); SEAM(2); }
    if (IN(3)) for (int rep = 0; rep < NREP(3); ++rep) {
        pg8::Gemm g{F.AC, F.Wout_t, MROWS, DM, DM}; pg8::StaticOrder S; S.init(MROWS, DM, F.G, (int)blockIdx.x);
        pg8::EpiResF32 E{F.xp, F.xs, F.out};
        pg8::gemm_phase<pg8::EpiResF32, pg8::StaticOrder, true, true>(F.lds + RING_OFF, g, S, E);
        SEAM(3);
    }
    if (IN(4)) for (int rep = 0; rep < NREP(4); ++rep) {
        const int gw = F.vcu * NWAVES + F.wave, NGW = F.G * NWAVES;
        for (int R = gw; R < MROWS; R += NGW) rms_row<true>(F.out + (size_t)R * DM, F.ln2_g, F.XN + (size_t)R * DM, F.lane);
        SEAM(4);
    }
    if (IN(5)) for (int rep = 0; rep < NREP(5); ++rep) {
        pg8::Gemm g{F.XN, F.Wup_t, MROWS, DFF, DM}; pg8::StaticOrder S; S.init(MROWS, DFF, F.G, (int)blockIdx.x);
        pg8::EpiRelu2 E{F.H, DFF};
        pg8::gemm_phase<pg8::EpiRelu2, pg8::StaticOrder, true, true>(F.lds + RING_OFF, g, S, E);
        SEAM(5);
    }
    if (IN(6)) {
        pg8::Gemm g{F.H, F.Wdn_t, MROWS, DM, DFF}; pg8::StaticOrder S; S.init(MROWS, DM, F.G, (int)blockIdx.x);
        pg8::EpiResF32 E{F.out, F.out + (size_t)pg8::PROMPT_ROWS * DM, F.out};
        pg8::gemm_phase<pg8::EpiResF32, pg8::StaticOrder, true, true>(F.lds + RING_OFF, g, S, E);
        SEAM(6);
    }
    if (IN(7)) {
        const int gw = F.vcu * NWAVES + F.wave, NGW = F.G * NWAVES;
        for (int R = gw; R < MROWS; R += NGW) rms_row<false>(F.out + (size_t)R * DM, F.lnf_g, F.out + (size_t)R * DM, F.lane);
    }
#undef IN
#undef SEAM
}

extern "C" void kernel_launch(void* const* d_in, const int* in_sizes, int n_in, void* d_out, int out_size, void* d_ws, size_t ws_size, hipStream_t stream) {
    static int grid = 0;
    if (grid == 0) {
        if (n_in != 22 || (size_t)out_size != O_END || ws_size < WS_END) { fprintf(stderr, "kernel_launch: unexpected shapes: n_in %d out %d ws %zu; nothing launched\n", n_in, out_size, ws_size); grid = -1; return; }
        int dev = 0, cus = 0, per_cu = 0;
        if (hipGetDevice(&dev) != hipSuccess || hipDeviceGetAttribute(&cus, hipDeviceAttributeMultiprocessorCount, dev) != hipSuccess) { fprintf(stderr, "kernel_launch: device query failed\n"); grid = -1; return; }
        if (hipFuncSetAttribute((const void*)fwd_kernel, hipFuncAttributeMaxDynamicSharedMemorySize, LDS_BYTES) != hipSuccess) { fprintf(stderr, "kernel_launch: hipFuncSetAttribute failed\n"); grid = -1; return; }
        if (hipOccupancyMaxActiveBlocksPerMultiprocessor(&per_cu, (const void*)fwd_kernel, NWAVES * 64, LDS_BYTES) != hipSuccess || per_cu < 1) { fprintf(stderr, "kernel_launch: occupancy query reports %d blocks per CU\n", per_cu); }
        (void)hipGetLastError();
        grid = cus;
    }
    if (grid < 0) return;
    (void)hipMemsetAsync((char*)d_ws + WS_CTL, 0, CTL_ZERO_BYTES, stream);
    Args a{};
    for (int i = 0; i < 22; ++i) a.in[i] = (const float*)d_in[i];
    a.out = (float*)d_out; a.ws = (unsigned char*)d_ws;
    for (int li = 0; li < N_LAUNCHES; ++li) {
        a.ph_lo = (N_LAUNCHES == 1) ? 0 : li; a.ph_hi = (N_LAUNCHES == 1) ? N_PHASES : li + 1; a.li = li;
        hipLaunchKernelGGL(fwd_kernel, dim3(grid), dim3(NWAVES * 64), LDS_BYTES, stream, a);
    }
}
```

```cpp
#include <hip/hip_runtime.h>
#include <hip/hip_bf16.h>
#include <cstdio>
#include <cstdint>
#include <cmath>
namespace pg8 {
#define PG8_LAS __attribute__((address_space(3)))
typedef unsigned short bf16_t;
typedef short bf16x8 __attribute__((ext_vector_type(8)));
typedef float f32x4 __attribute__((ext_vector_type(4)));
typedef unsigned u32x4 __attribute__((ext_vector_type(4)));
constexpr int BM = 256, BK = 64, HALF = 128, HTB = HALF * BK * 2  , STAGE_BYTES = 8 * HTB, NXCD = 8, WGM = 8;

__host__ __device__ __forceinline__ int lds_byte(int r, int c) { const int st = (r >> 4) * 2 + (c >> 5), rr = r & 15, cc = c & 31, ob = rr * 64 + cc * 2; return st * 1024 + (ob ^ (((ob >> 9) & 1) << 5)); }
__host__ __device__ __forceinline__ void stage_rc(int b, int& R, int& C) { const int st = b / 1024, sb = b % 1024, swz = sb ^ (((sb >> 9) & 1) << 5); R = (st >> 1) * 16 + swz / 64; C = (st & 1) * 32 + (swz % 64) / 2; }
__host__ __device__ __forceinline__ int perm32(int rho) { const int n = rho >> 4, i = rho & 15; return 8 * (i >> 2) + 4 * n + (i & 3); }

struct Unit { int pm, pn; };
struct Gemm { const bf16_t* A; const bf16_t* Bt; int M, N, K; };

struct StaticOrder {
    int nM, nN, nwg, G, c;
    __host__ __device__ void init(int M, int N, int G_, int c_) { nM = M / BM; nN = N / BM; nwg = nM * nN; G = G_; c = c_; }
    __host__ __device__ bool next(int i, Unit& u) const {
        const long L = (long)i * G + c; if (L >= nwg) return false;
        int wgid = (int)L; { const int q = nwg / NXCD, r = nwg % NXCD, xcd = wgid % NXCD, off = wgid / NXCD; wgid = (xcd < r ? xcd * (q + 1) : r * (q + 1) + (xcd - r) * q) + off; }
        const int nig = WGM * nN, gid = wgid / nig, fm = gid * WGM, gsz = (nM - fm) < WGM ? (nM - fm) : WGM;
        u.pm = fm + ((wgid % nig) % gsz); u.pn = (wgid % nig) / gsz; return true;
    }
    __device__ __forceinline__ void a_ready(const Unit&) const {}
    __device__ __forceinline__ void done(const Unit&) const {}
};


__device__ __forceinline__ unsigned cvt_pk_bf16(float lo, float hi) { unsigned r; asm volatile("v_cvt_pk_bf16_f32 %0, %1, %2" : "=v"(r) : "v"(lo), "v"(hi)); return r; }
__device__ __forceinline__ u32x4 pack8(const f32x4 v0, const f32x4 v1) { u32x4 w; w.x = cvt_pk_bf16(v0[0], v0[1]); w.y = cvt_pk_bf16(v0[2], v0[3]); w.z = cvt_pk_bf16(v1[0], v1[1]); w.w = cvt_pk_bf16(v1[2], v1[3]); return w; }
__device__ __forceinline__ float sigmoidf_fast(float g) { return __builtin_amdgcn_rcpf(1.0f + __builtin_amdgcn_exp2f(-1.4426950408889634f * g)); }

constexpr int PROMPT_ROWS = 32768;
constexpr int KC_ROWS = 2112;

struct EpiProj {
    static constexpr bool PERM = true, AFTER_DRAIN = false;
    bf16_t *Q, *Kp, *Vp, *Kc, *Vc, *U; float *okp, *ovp, *oks, *ovs; float qscale;
    __device__ __forceinline__ void operator()(const f32x4 (&acc)[2][2][4][2], const Unit& u, int wr, int wc, int fr, int fq) const {
        const int pn = u.pn; const bool sample = u.pm >= PROMPT_ROWS / BM;
        const int row0 = u.pm * BM + wr * 64 + fr, cl = wc * 32 + 8 * fq;
        if (pn < 2) {
#pragma unroll
            for (int ai = 0; ai < 2; ++ai)
#pragma unroll
                for (int m = 0; m < 4; ++m) { bf16_t* rp = Q + (size_t)(row0 + ai * HALF + m * 16) * 512 + pn * 256 + cl;
#pragma unroll
                    for (int bj = 0; bj < 2; ++bj) *(u32x4*)(rp + bj * HALF) = pack8(acc[ai][bj][m][0] * qscale, acc[ai][bj][m][1] * qscale); }
        } else if (pn < 6) {
            const bool isV = pn >= 4; const int c0 = (pn & 1) * 256 + cl;
#pragma unroll
            for (int ai = 0; ai < 2; ++ai)
#pragma unroll
                for (int m = 0; m < 4; ++m) { const int R = row0 + ai * HALF + m * 16; bf16_t* bp; float* fp;
                    if (!sample) { bp = (isV ? Vp : Kp) + (size_t)R * 512 + c0; fp = (isV ? ovp : okp) + (size_t)R * 512 + c0; }
                    else { const int s = R - PROMPT_ROWS, b = s >> 5, t = s & 31; bp = (isV ? Vc : Kc) + (size_t)(b * KC_ROWS + 2048 + t) * 512 + c0; fp = (isV ? ovs : oks) + (size_t)s * 512 + c0; }
#pragma unroll
                    for (int bj = 0; bj < 2; ++bj) { const f32x4 v0 = acc[ai][bj][m][0], v1 = acc[ai][bj][m][1];
                        *(u32x4*)(bp + bj * HALF) = pack8(v0, v1); *(f32x4*)(fp + bj * HALF) = v0; *(f32x4*)(fp + bj * HALF + 4) = v1; } }
        } else {
            const int c0 = (pn - 6) * 128 + cl;
#pragma unroll
            for (int ai = 0; ai < 2; ++ai)
#pragma unroll
                for (int m = 0; m < 4; ++m) { const int R = row0 + ai * HALF + m * 16; f32x4 o0, o1;
#pragma unroll
                    for (int i = 0; i < 4; ++i) { o0[i] = acc[ai][0][m][0][i] * sigmoidf_fast(acc[ai][1][m][0][i]); o1[i] = acc[ai][0][m][1][i] * sigmoidf_fast(acc[ai][1][m][1][i]); }
                    *(u32x4*)(U + (size_t)R * 512 + c0) = pack8(o0, o1); }
        }
    }
};
struct EpiRes1 {
    static constexpr bool PERM = true, AFTER_DRAIN = false;
    const float* resP; const float* resS; bf16_t* XB; float* ssq;
    __device__ __forceinline__ void operator()(const f32x4 (&acc)[2][2][4][2], const Unit& u, int wr, int wc, int fr, int fq) const {
        const int row0 = u.pm * BM + wr * 64 + fr, col0 = u.pn * BM + wc * 32 + 8 * fq;
        const float* rbase = (u.pm >= PROMPT_ROWS / BM) ? resS - (size_t)PROMPT_ROWS * 1024 : resP;
#pragma unroll
        for (int ai = 0; ai < 2; ++ai)
#pragma unroll
            for (int m = 0; m < 4; ++m) { const int R = row0 + ai * HALF + m * 16; const size_t off = (size_t)R * 1024 + col0; float q = 0.f;
#pragma unroll
                for (int bj = 0; bj < 2; ++bj) { const f32x4 r0 = *(const f32x4*)(rbase + off + bj * HALF), r1 = *(const f32x4*)(rbase + off + bj * HALF + 4);
                    const f32x4 v0 = r0 + acc[ai][bj][m][0], v1 = r1 + acc[ai][bj][m][1];
                    q += (v0[0] * v0[0] + v0[1] * v0[1]) + (v0[2] * v0[2] + v0[3] * v0[3]) + (v1[0] * v1[0] + v1[1] * v1[1]) + (v1[2] * v1[2] + v1[3] * v1[3]);
                    *(u32x4*)(XB + off + bj * HALF) = pack8(v0, v1); }
                q += __shfl_xor(q, 16); q += __shfl_xor(q, 32);
                if (fq == 0) ssq[(size_t)R * 16 + u.pn * 4 + wc] = q; }
    }
};
struct EpiRelu2 {
    static constexpr bool PERM = true, AFTER_DRAIN = false;
    bf16_t* O; int ldc; const float* ssq; float eps;
    __device__ __forceinline__ void operator()(const f32x4 (&acc)[2][2][4][2], const Unit& u, int wr, int wc, int fr, int fq) const {
        const int row0 = u.pm * BM + wr * 64 + fr, col0 = u.pn * BM + wc * 32 + 8 * fq;
#pragma unroll
        for (int ai = 0; ai < 2; ++ai)
#pragma unroll
            for (int m = 0; m < 4; ++m) { const int R = row0 + ai * HALF + m * 16; const f32x4* sp = (const f32x4*)(ssq + (size_t)R * 16);
                const f32x4 s0 = sp[0], s1 = sp[1], s2 = sp[2], s3 = sp[3]; const f32x4 st = (s0 + s1) + (s2 + s3);
                const float rstd = 1.0f / sqrtf(((st[0] + st[1]) + (st[2] + st[3])) * (1.0f / 1024.0f) + eps);
                bf16_t* rp = O + (size_t)R * ldc + col0;
#pragma unroll
                for (int bj = 0; bj < 2; ++bj) { f32x4 v0 = acc[ai][bj][m][0], v1 = acc[ai][bj][m][1];
#pragma unroll
                    for (int i = 0; i < 4; ++i) { const float a = fmaxf(v0[i], 0.f) * rstd, b = fmaxf(v1[i], 0.f) * rstd; v0[i] = a * a; v1[i] = b * b; }
                    *(u32x4*)(rp + bj * HALF) = pack8(v0, v1); } }
    }
};
struct EpiRes2 {
    static constexpr bool PERM = true, AFTER_DRAIN = false;
    const bf16_t* XB; float* out;
    __device__ __forceinline__ void operator()(const f32x4 (&acc)[2][2][4][2], const Unit& u, int wr, int wc, int fr, int fq) const {
        const int row0 = u.pm * BM + wr * 64 + fr, col0 = u.pn * BM + wc * 32 + 8 * fq;
#pragma unroll
        for (int ai = 0; ai < 2; ++ai)
#pragma unroll
            for (int m = 0; m < 4; ++m) { const size_t off = (size_t)(row0 + ai * HALF + m * 16) * 1024 + col0;
#pragma unroll
                for (int bj = 0; bj < 2; ++bj) { const u32x4 w = *(const u32x4*)(XB + off + bj * HALF); f32x4 r0, r1;
                    r0[0] = __builtin_bit_cast(float, w.x << 16); r0[1] = __builtin_bit_cast(float, w.x & 0xffff0000u); r0[2] = __builtin_bit_cast(float, w.y << 16); r0[3] = __builtin_bit_cast(float, w.y & 0xffff0000u);
                    r1[0] = __builtin_bit_cast(float, w.z << 16); r1[1] = __builtin_bit_cast(float, w.z & 0xffff0000u); r1[2] = __builtin_bit_cast(float, w.w << 16); r1[3] = __builtin_bit_cast(float, w.w & 0xffff0000u);
                    *(f32x4*)(out + off + bj * HALF) = r0 + acc[ai][bj][m][0]; *(f32x4*)(out + off + bj * HALF + 4) = r1 + acc[ai][bj][m][1]; } }
    }
};

template <class Epi, class Sched, bool ALIGN_EPI = false, bool SP2 = false>
__device__ __forceinline__ void gemm_phase(PG8_LAS unsigned char* lds, const Gemm g, const Sched& S, const Epi& E) {
    const int tid = threadIdx.x, wid = __builtin_amdgcn_readfirstlane(tid >> 6), lane = tid & 63, wr = wid >> 2, wc = wid & 3, fr = lane & 15, fq = lane >> 4;
    const int K = g.K, nt = K / BK;
    unsigned voffA[2], voffB[2];
#pragma unroll
    for (int i = 0; i < 2; ++i) { int R, C; stage_rc(tid * 16 + i * 8192, R, C); const int Rb = Epi::PERM ? ((R & ~31) + perm32(R & 31)) : R;
        voffA[i] = (unsigned)(R * K + C) * 2u; voffB[i] = (unsigned)(Rb * K + C) * 2u; }
    const size_t kstep = (size_t)(BK * 2);
    const size_t hstep = (size_t)HALF * K * 2;
    const size_t tstep = 2 * hstep;
    const unsigned ldsw = (unsigned)wid * 1024u;
    const int aoff = lds_byte(wr * 64 + fr, fq * 8), boff = lds_byte(wc * 32 + fr, fq * 8);
#define PG8_SA(b, h) (((b) * 2 + (h)) * HTB)
#define PG8_SB(b, h) ((4 + (b) * 2 + (h)) * HTB)
#define PG8_STAGE(bufoff, gbase, voff) do { _Pragma("unroll") for (int _i = 0; _i < 2; ++_i) \
        __builtin_amdgcn_global_load_lds((const unsigned*)((const char*)(gbase) + (voff)[_i]), (PG8_LAS unsigned*)(lds + (bufoff) + ldsw + _i * 8192), 16, 0, 0); } while (0)
#define PG8_LDA(dst, b, h) do { _Pragma("unroll") for (int m = 0; m < 4; ++m) _Pragma("unroll") for (int k = 0; k < 2; ++k) dst[m][k] = *(const PG8_LAS bf16x8*)(lds + PG8_SA(b, h) + aoff + m * 2048 + k * 1024); } while (0)
#define PG8_LDB(dst, b, h) do { _Pragma("unroll") for (int n = 0; n < 2; ++n) _Pragma("unroll") for (int k = 0; k < 2; ++k) dst[n][k] = *(const PG8_LAS bf16x8*)(lds + PG8_SB(b, h) + boff + n * 2048 + k * 1024); } while (0)
#define PG8_MMA(ai, bj, At, Bt) do { __builtin_amdgcn_s_setprio(1); _Pragma("unroll") for (int m = 0; m < 4; ++m) _Pragma("unroll") for (int n = 0; n < 2; ++n) _Pragma("unroll") for (int k = 0; k < 2; ++k) \
        acc[ai][bj][m][n] = __builtin_amdgcn_mfma_f32_16x16x32_bf16(Bt[n][k], At[m][k], acc[ai][bj][m][n], 0, 0, 0); __builtin_amdgcn_s_setprio(0); } while (0)
#define PG8_WAIT_V(n) asm volatile("s_waitcnt vmcnt(" #n ")" ::: "memory")
#define PG8_WAIT_L(n) asm volatile("s_waitcnt lgkmcnt(" #n ")" ::: "memory")
#define PG8_BAR __builtin_amdgcn_s_barrier()
#define PG8_SCHED __builtin_amdgcn_sched_barrier(0)
    Unit cur, nxt; int ui = 0;
    if (!S.next(0, cur)) return;
    f32x4 acc[2][2][4][2];
#pragma unroll
    for (int a = 0; a < 2; ++a)
#pragma unroll
        for (int b = 0; b < 2; ++b)
#pragma unroll
            for (int m = 0; m < 4; ++m)
#pragma unroll
                for (int n = 0; n < 2; ++n) acc[a][b][m][n] = (f32x4){0.f, 0.f, 0.f, 0.f};
    bf16x8 At[4][2], B0[2][2], B1[2][2];
    const char* cA = (const char*)g.A + (size_t)cur.pm * tstep; const char* cB = (const char*)g.Bt + (size_t)cur.pn * tstep;
    S.a_ready(cur);
    if constexpr (SP2) {
        PG8_STAGE(PG8_SB(0, 0), cB, voffB); PG8_STAGE(PG8_SB(0, 1), cB + hstep, voffB); PG8_STAGE(PG8_SA(0, 0), cA, voffA); PG8_STAGE(PG8_SA(0, 1), cA + hstep, voffA);
        if (wr == 1) PG8_BAR;
        PG8_WAIT_V(2); PG8_BAR;
        PG8_STAGE(PG8_SB(1, 0), cB + kstep, voffB); PG8_STAGE(PG8_SA(1, 0), cA + kstep, voffA); PG8_STAGE(PG8_SB(1, 1), cB + hstep + kstep, voffB);
        PG8_WAIT_V(6); PG8_BAR;
    } else {
        PG8_STAGE(PG8_SB(0, 0), cB, voffB); PG8_STAGE(PG8_SA(0, 0), cA, voffA); PG8_STAGE(PG8_SB(0, 1), cB + hstep, voffB); PG8_STAGE(PG8_SA(0, 1), cA + hstep, voffA);
        if (wr == 1) PG8_BAR;
        PG8_WAIT_V(4); PG8_BAR;
        PG8_STAGE(PG8_SB(1, 0), cB + kstep, voffB); PG8_STAGE(PG8_SA(1, 0), cA + kstep, voffA); PG8_STAGE(PG8_SB(1, 1), cB + hstep + kstep, voffB);
        PG8_WAIT_V(6); PG8_BAR;
    }
    for (;;) {
        const bool has_next = S.next(ui + 1, nxt);
        const char* nA = has_next ? (const char*)g.A + (size_t)nxt.pm * tstep : cA; const char* nB = has_next ? (const char*)g.Bt + (size_t)nxt.pn * tstep : cB;
        for (int t = 0; t < nt; t += 2) {
            const bool last = (t == nt - 2);
            const char* a1 = cA + (size_t)(t + 1) * kstep;
            const char* a2 = last ? nA : cA + (size_t)(t + 2) * kstep; const char* b2 = last ? nB : cB + (size_t)(t + 2) * kstep;
            const char* a3 = a2 + kstep; const char* b3 = b2 + kstep;
            if (last && has_next) S.a_ready(nxt);
            if constexpr (SP2) {
            PG8_LDB(B0, 0, 0); PG8_LDB(B1, 0, 1); PG8_SCHED; PG8_LDA(At, 0, 0); PG8_STAGE(PG8_SA(1, 1), a1 + hstep, voffA);
            PG8_WAIT_V(8); PG8_WAIT_L(0); PG8_BAR; PG8_MMA(0, 0, At, B0); PG8_MMA(0, 1, At, B1); PG8_BAR; PG8_SCHED;
            PG8_LDA(At, 0, 1); PG8_STAGE(PG8_SB(0, 0), b2, voffB); PG8_STAGE(PG8_SB(0, 1), b2 + hstep, voffB); PG8_STAGE(PG8_SA(0, 0), a2, voffA);
            PG8_WAIT_V(8); PG8_WAIT_L(0); PG8_BAR; PG8_MMA(1, 0, At, B0); PG8_MMA(1, 1, At, B1); PG8_BAR; PG8_SCHED;
            PG8_LDB(B0, 1, 0); PG8_LDB(B1, 1, 1); PG8_SCHED; PG8_LDA(At, 1, 0); PG8_STAGE(PG8_SA(0, 1), a2 + hstep, voffA);
            PG8_WAIT_V(8); PG8_WAIT_L(0); PG8_BAR; PG8_MMA(0, 0, At, B0); PG8_MMA(0, 1, At, B1); PG8_BAR; PG8_SCHED;
            PG8_LDA(At, 1, 1); PG8_STAGE(PG8_SB(1, 0), b3, voffB); PG8_STAGE(PG8_SB(1, 1), b3 + hstep, voffB); PG8_STAGE(PG8_SA(1, 0), a3, voffA);
            PG8_WAIT_V(8); PG8_WAIT_L(0); PG8_BAR; PG8_MMA(1, 0, At, B0); PG8_MMA(1, 1, At, B1); PG8_BAR; PG8_SCHED;
            } else {
            PG8_LDB(B0, 0, 0); PG8_SCHED; PG8_LDA(At, 0, 0); PG8_STAGE(PG8_SA(1, 1), a1 + hstep, voffA);
            PG8_WAIT_L(8); PG8_BAR; PG8_WAIT_L(0); PG8_MMA(0, 0, At, B0); PG8_BAR; PG8_SCHED;
            PG8_LDB(B1, 0, 1); PG8_STAGE(PG8_SB(0, 0), b2, voffB);
            PG8_BAR; PG8_WAIT_L(0); PG8_MMA(0, 1, At, B1); PG8_BAR;
            PG8_LDA(At, 0, 1); PG8_STAGE(PG8_SA(0, 0), a2, voffA);
            PG8_BAR; PG8_WAIT_L(0); PG8_MMA(1, 0, At, B0); PG8_BAR; PG8_SCHED;
            PG8_STAGE(PG8_SB(0, 1), b2 + hstep, voffB);
            PG8_WAIT_V(6); PG8_BAR; PG8_MMA(1, 1, At, B1); PG8_BAR;
            PG8_LDB(B0, 1, 0); PG8_SCHED; PG8_LDA(At, 1, 0); PG8_STAGE(PG8_SA(0, 1), a2 + hstep, voffA);
            PG8_WAIT_L(8); PG8_BAR; PG8_WAIT_L(0); PG8_MMA(0, 0, At, B0); PG8_BAR; PG8_SCHED;
            PG8_LDB(B1, 1, 1); PG8_STAGE(PG8_SB(1, 0), b3, voffB);
            PG8_BAR; PG8_WAIT_L(0); PG8_MMA(0, 1, At, B1); PG8_BAR;
            PG8_LDA(At, 1, 1); PG8_STAGE(PG8_SA(1, 0), a3, voffA);
            PG8_BAR; PG8_WAIT_L(0); PG8_MMA(1, 0, At, B0); PG8_BAR; PG8_SCHED;
            PG8_STAGE(PG8_SB(1, 1), b3 + hstep, voffB);
            PG8_WAIT_V(6); PG8_BAR; PG8_MMA(1, 1, At, B1); PG8_BAR;
            }
        }
        if constexpr (ALIGN_EPI) { if (wr == 0) PG8_BAR; }
        if constexpr (!Epi::AFTER_DRAIN) { E(acc, cur, wr, wc, fr, fq); S.done(cur); }
        if (!has_next) break;
#pragma unroll
        for (int a = 0; a < 2; ++a)
#pragma unroll
            for (int b = 0; b < 2; ++b)
#pragma unroll
                for (int m = 0; m < 4; ++m)
#pragma unroll
                    for (int n = 0; n < 2; ++n) acc[a][b][m][n] = (f32x4){0.f, 0.f, 0.f, 0.f};
        cur = nxt; cA = nA; cB = nB; ++ui;
        if constexpr (ALIGN_EPI) { if (wr == 1) PG8_BAR; }
    }
    PG8_WAIT_V(0);
    if constexpr (!ALIGN_EPI) { if (wr == 0) PG8_BAR; }
    PG8_BAR;
    if constexpr (Epi::AFTER_DRAIN) { E.fused(acc, cur, wr, wc, fr, fq, lds, wid, lane); S.done(cur); }
#undef PG8_SA
#undef PG8_SB
#undef PG8_STAGE
#undef PG8_LDA
#undef PG8_LDB
#undef PG8_MMA
#undef PG8_WAIT_V
#undef PG8_WAIT_L
#undef PG8_BAR
#undef PG8_SCHED
}
}

constexpr int DM = 1024, NSEQ_P = 16, TP = 2048, NSEQ_S = 32, TS = 32, PAST = 2048;
constexpr int MROWS = NSEQ_P * TP + NSEQ_S * TS;
constexpr int NH = 4, INCOLS = 2560, DFF = 4096, CW = 31, CPAD = 30, WB = 512;
constexpr float EPS = 1e-6f, LAM_INIT = 0.2f;
constexpr float LOG2E = 1.4426950408889634f;
constexpr size_t O_YP = 0, O_YS = (size_t)NSEQ_P * TP * DM, O_KP = O_YS + (size_t)NSEQ_S * TS * DM, O_VP = O_KP + (size_t)NSEQ_P * TP * 512,
                 O_CP = O_VP + (size_t)NSEQ_P * TP * 512, O_KS = O_CP + (size_t)NSEQ_P * CPAD * WB, O_VS = O_KS + (size_t)NSEQ_S * TS * 512,
                 O_CS = O_VS + (size_t)NSEQ_S * TS * 512, O_END = O_CS + (size_t)NSEQ_S * CPAD * WB;
static_assert(O_END == 69943296, "output size");
constexpr size_t MiB = 1u << 20;
constexpr size_t WS_CTL = 0, CTL_ZERO_BYTES = 1 * MiB;
constexpr size_t WS_SSQ = 1 * MiB + 512 * 1024;
constexpr size_t WS_WIN = 4 * MiB, WS_WOUT = 9 * MiB, WS_WUP = 11 * MiB, WS_WDN = 19 * MiB;
constexpr size_t WS_XN = 27 * MiB;
constexpr size_t WS_H = 93 * MiB;
constexpr size_t WS_Q = 93 * MiB, WS_KP = 126 * MiB, WS_VP = 158 * MiB, WS_KC = 190 * MiB, WS_VC = 256 * MiB, WS_U = 322 * MiB, WS_AC = 355 * MiB, WS_END = 421 * MiB;
static_assert(WS_SSQ + (size_t)MROWS * 16 * 4 <= WS_WIN && WS_WDN + (size_t)DM * DFF * 2 <= WS_XN && WS_XN + (size_t)MROWS * DM * 2 <= WS_H && WS_H + (size_t)MROWS * DFF * 2 <= WS_END && WS_KC + (size_t)NSEQ_S * pg8::KC_ROWS * 512 * 2 <= WS_VC && WS_VC + (size_t)NSEQ_S * pg8::KC_ROWS * 512 * 2 <= WS_U && WS_U + (size_t)MROWS * 512 * 2 <= WS_AC && WS_AC + (size_t)MROWS * DM * 2 <= WS_END, "ws map");
constexpr int CW_TMO = 0, CW_CODE = 1, CW_BAR = 4096;

constexpr int RING_OFF = 0, RING_BYTES = 131072;
constexpr int LDSCTL_OFF = RING_BYTES, MISC_OFF = LDSCTL_OFF + 320;
constexpr int LDS_BYTES = 147456;
constexpr int NWAVES = 8;

#define GAS __attribute__((address_space(1)))
#define LAS __attribute__((address_space(3)))
typedef unsigned short bf16;
typedef unsigned v4u __attribute__((ext_vector_type(4)));
typedef float f32x4 __attribute__((ext_vector_type(4)));
typedef float f32x16 __attribute__((ext_vector_type(16)));
typedef short bf16x8 __attribute__((ext_vector_type(8)));
typedef short s16x4 __attribute__((ext_vector_type(4)));
typedef GAS unsigned gu32;
#define RLX_AGENT __ATOMIC_RELAXED, __HIP_MEMORY_SCOPE_AGENT
#define LDS_WAIT() asm volatile("s_waitcnt lgkmcnt(0)" ::: "memory")
#define VM_WAIT() asm volatile("s_waitcnt vmcnt(0)" ::: "memory")
__device__ __forceinline__ unsigned f2bf(float f) { unsigned u = __builtin_bit_cast(unsigned, f); return (u + 0x7fffu + ((u >> 16) & 1u)) >> 16; }
__device__ __forceinline__ unsigned pk2(float lo, float hi) { return f2bf(lo) | (f2bf(hi) << 16); }
__device__ __forceinline__ float bf2f(unsigned short h) { return __builtin_bit_cast(float, (unsigned)h << 16); }

namespace att {
constexpr int SLOTK = 16384, SLOTV = 16384;
constexpr int L_K = 0, L_V = 2 * SLOTK, L_WS = L_V + 2 * SLOTV, L_TAB = L_WS + 2048, L_END = L_TAB + 4 * 192 * 4;
static_assert(L_END <= RING_BYTES, "attention LDS");
__device__ __forceinline__ int crow(int r, int hi) { return (r & 3) + 8 * (r >> 2) + 4 * hi; }
typedef float f32x2_t __attribute__((ext_vector_type(2))); typedef __bf16 bf16x2_t __attribute__((ext_vector_type(2)));
__device__ __forceinline__ unsigned cvtpk_s(float lo, float hi) { f32x2_t v = {lo, hi}; bf16x2_t b = __builtin_convertvector(v, bf16x2_t); return __builtin_bit_cast(unsigned, b); }
typedef short v4i16_t __attribute__((ext_vector_type(4)));
__device__ __forceinline__ s16x4 vtr(const LAS unsigned char* p) { return __builtin_bit_cast(s16x4, __builtin_amdgcn_ds_read_tr16_b64_v4i16((LAS v4i16_t*)p)); }
__device__ __forceinline__ void glds(const bf16* g, LAS unsigned char* l) { __builtin_amdgcn_global_load_lds((const unsigned*)g, (LAS unsigned*)l, 16, 0, 0); }
__device__ __forceinline__ int t5_bucket(int delta) {
    int n = -delta, ret = 0; if (n < 0) { ret = 16; n = -n; }
    const int v = n < 8 ? n : (n < 12 ? 8 : n < 16 ? 9 : n < 23 ? 10 : n < 32 ? 11 : n < 46 ? 12 : n < 64 ? 13 : n < 91 ? 14 : 15);
    return ret + v;
}
struct AUnit { const bf16* Q; const bf16* K; const bf16* V; bf16* O; int h, NT, nkeys, qpos0, nrb; };

__device__ __forceinline__ void attn_unit(const AUnit& u, LAS unsigned char* lds, float lam, const float* __restrict__ subg) {
    const int tid = threadIdx.x, lane = tid & 63, r32 = lane & 31, hi = lane >> 5;
    const int wid = __builtin_amdgcn_readfirstlane(tid >> 6), mp = wid & 1, rb = wid >> 1;
    const bool active = rb < u.nrb;
    const int qbase = u.qpos0 + 32 * rb, chunk = qbase >> 6;
    LAS float* wsf = (LAS float*)(lds + L_WS) + wid * 64;
    const LAS float* tab = (const LAS float*)(lds + L_TAB) + u.h * 192;
    const bf16* ksrc = u.K + (size_t)lane * 512 + u.h * 128 + wid * 8;
    const bf16* vsrc = u.V + (size_t)(16 * (wid & 3) + (lane >> 2)) * 512 + u.h * 128 + (wid >> 2) * 32 + (lane & 3) * 8;
#define ATT_DMA(t, slot) do { const size_t go_ = (size_t)(t) * 64 * 512; \
        glds(ksrc + go_, lds + L_K + (slot) * SLOTK + wid * 1024); glds(ksrc + go_ + 64, lds + L_K + (slot) * SLOTK + 8192 + wid * 1024); \
        glds(vsrc + go_, lds + L_V + (slot) * SLOTV + wid * 1024); glds(vsrc + go_ + 64, lds + L_V + (slot) * SLOTV + 8192 + wid * 1024); } while (0)
    bf16x8 qr[4];
#pragma unroll
    for (int d0 = 0; d0 < 4; ++d0) qr[d0] = active ? *(const bf16x8*)(u.Q + (size_t)(32 * rb + r32) * 512 + u.h * 128 + mp * 64 + d0 * 16 + hi * 8) : (bf16x8){0, 0, 0, 0, 0, 0, 0, 0};
    float m = -1e30f, l = 0.f; f32x16 o[4];
#pragma unroll
    for (int d = 0; d < 4; ++d) o[d] = f32x16{};
    ATT_DMA(0, 0);
    for (int t = 0; t < u.NT; ++t) {
        asm volatile("s_waitcnt vmcnt(0) lgkmcnt(0)\n\ts_barrier" ::: "memory");
        if (t + 1 < u.NT) ATT_DMA(t + 1, (t + 1) & 1);
        if (active && t <= chunk) {
            const int slot = t & 1;
            const LAS unsigned char* kb = lds + L_K + slot * SLOTK + mp * 8192 + hi * 1024 + r32 * 16;
            f32x16 p0 = f32x16{}, p1 = f32x16{};
#pragma unroll
            for (int d0 = 0; d0 < 4; ++d0) { const bf16x8 b0 = *(const LAS bf16x8*)(kb + d0 * 2048), b1 = *(const LAS bf16x8*)(kb + d0 * 2048 + 512);
                p0 = __builtin_amdgcn_mfma_f32_32x32x16_bf16(b0, qr[d0], p0, 0, 0, 0); p1 = __builtin_amdgcn_mfma_f32_32x32x16_bf16(b1, qr[d0], p1, 0, 0, 0); }
            const int kq = 64 * t - qbase;
            if (kq + 63 <= -128) { const float c = tab[0];
#pragma unroll
                for (int r = 0; r < 16; ++r) { p0[r] += c; p1[r] += c; } }
            else { const int dl = kq - r32 + 128;
#pragma unroll
                for (int r = 0; r < 16; ++r) { const int j = dl + crow(r, hi); const int i0 = min(max(j, 0), 191), i1 = min(max(j + 32, 0), 191); p0[r] += tab[i0]; p1[r] += tab[i1]; } }
            if (64 * t + 64 > u.nkeys) {
#pragma unroll
                for (int r = 0; r < 16; ++r) { const int j = 64 * t + crow(r, hi); if (j >= u.nkeys) p0[r] = -1e30f; if (j + 32 >= u.nkeys) p1[r] = -1e30f; } }
            float rm = fmaxf(p0[0], p1[0]);
#pragma unroll
            for (int r = 1; r < 16; ++r) rm = fmaxf(rm, fmaxf(p0[r], p1[r]));
            { auto rr = __builtin_amdgcn_permlane32_swap(__float_as_uint(rm), __float_as_uint(rm), false, false); rm = fmaxf(__uint_as_float(rr[0]), __uint_as_float(rr[1])); }
            const float mn = fmaxf(m, rm), alpha = __builtin_amdgcn_exp2f(m - mn); m = mn;
            float rs = 0.f;
#pragma unroll
            for (int r = 0; r < 16; ++r) { p0[r] = __builtin_amdgcn_exp2f(p0[r] - mn); p1[r] = __builtin_amdgcn_exp2f(p1[r] - mn); rs += p0[r] + p1[r]; }
            l = l * alpha + rs;
            if (__builtin_amdgcn_ballot_w64(alpha != 1.0f) != 0ull) {
                if (hi == 0) wsf[r32] = alpha;
#pragma unroll
                for (int r = 0; r < 16; ++r) { const float a = wsf[crow(r, hi)];
#pragma unroll
                    for (int d = 0; d < 4; ++d) o[d][r] *= a; }
            }
            v4u pw[4];
#pragma unroll
            for (int i = 0; i < 4; ++i) { pw[0][i] = cvtpk_s(p0[2 * i], p0[2 * i + 1]); pw[1][i] = cvtpk_s(p0[8 + 2 * i], p0[9 + 2 * i]); pw[2][i] = cvtpk_s(p1[2 * i], p1[2 * i + 1]); pw[3][i] = cvtpk_s(p1[8 + 2 * i], p1[9 + 2 * i]); }
            const LAS unsigned char* vp = lds + L_V + slot * SLOTV + ((lane >> 4) & 1) * 32 + (lane & 3) * 8 + (4 * hi + ((lane & 15) >> 2)) * 64;
#pragma unroll
            for (int d = 0; d < 4; ++d)
#pragma unroll
                for (int ks = 0; ks < 4; ++ks) { const s16x4 lo = vtr(vp + d * 4096 + ks * 1024), h4 = vtr(vp + d * 4096 + ks * 1024 + 512);
                    const bf16x8 vf = (bf16x8){lo[0], lo[1], lo[2], lo[3], h4[0], h4[1], h4[2], h4[3]};
                    o[d] = __builtin_amdgcn_mfma_f32_32x32x16_bf16(__builtin_bit_cast(bf16x8, pw[ks]), vf, o[d], 0, 0, 0); }
        }
    }
#undef ATT_DMA
    __syncthreads();
    { auto rr = __builtin_amdgcn_permlane32_swap(__float_as_uint(l), __float_as_uint(l), false, false); l = __uint_as_float(rr[0]) + __uint_as_float(rr[1]); }
    if (active) {
        if (hi == 0) wsf[r32] = 1.0f / l;
#pragma unroll
        for (int r = 0; r < 16; ++r) { const float a = wsf[crow(r, hi)];
#pragma unroll
            for (int d = 0; d < 4; ++d) o[d][r] *= a; }
        if (mp == 1) { LAS float* X = (LAS float*)lds + rb * 4096;
#pragma unroll
            for (int d = 0; d < 4; ++d)
#pragma unroll
                for (int r = 0; r < 16; ++r) X[(d * 16 + r) * 64 + lane] = o[d][r]; }
    }
    __syncthreads();
    if (active && mp == 0) {
        const LAS float* X = (const LAS float*)lds + rb * 4096;
        float ss[16];
#pragma unroll
        for (int r = 0; r < 16; ++r) ss[r] = 0.f;
#pragma unroll
        for (int d = 0; d < 4; ++d)
#pragma unroll
            for (int r = 0; r < 16; ++r) { const float a = o[d][r] - lam * X[(d * 16 + r) * 64 + lane]; o[d][r] = a; ss[r] += a * a; }
#pragma unroll
        for (int off = 1; off < 32; off <<= 1)
#pragma unroll
            for (int r = 0; r < 16; ++r) ss[r] += __shfl_xor(ss[r], off);
        float g[4];
#pragma unroll
        for (int d = 0; d < 4; ++d) g[d] = subg[32 * d + r32] * (1.0f - LAM_INIT);
#pragma unroll
        for (int r = 0; r < 16; ++r) { const float rstd = 1.0f / sqrtf(ss[r] * (1.0f / 128.0f) + EPS); bf16* op = u.O + (size_t)(32 * rb + crow(r, hi)) * 1024 + u.h * 128 + r32;
#pragma unroll
            for (int d = 0; d < 4; ++d) op[32 * d] = (bf16)f2bf(o[d][r] * rstd * g[d]); }
    }
    __syncthreads();
}
}
#define XB_TMO      128
#define XB_XCNT(j)  (256  + 64 * (j))
#define XB_XSUB(j)  (1280 + 64 * (j))
#define XB_XGEN(j)  (2304 + 64 * (j))
#define XB_TOP      3328
#define XB_TOPGEN   3392
#define XCD_BAR_WORDS 3456
#define XB_SPIN_CAP (1u << 18)

__device__ __forceinline__ unsigned xb_ld(unsigned* p)              { return __hip_atomic_load(p, __ATOMIC_RELAXED, __HIP_MEMORY_SCOPE_AGENT); }
__device__ __forceinline__ unsigned xb_add(unsigned* p, unsigned v) { return __hip_atomic_fetch_add(p, v, __ATOMIC_RELAXED, __HIP_MEMORY_SCOPE_AGENT); }
__device__ __forceinline__ unsigned xb_xcc_id() { return (unsigned)__builtin_amdgcn_s_getreg((3 << 11) | 20) & 0xFu; }
#define XB_SPIN(cond, bar) do { unsigned _sp = 0; while (cond) { __builtin_amdgcn_s_sleep(1); \
    if ((++_sp & 255u) == 0u) { if (xb_ld(&(bar)[XB_TMO])) break; if (_sp > XB_SPIN_CAP) { atomicAdd(&(bar)[XB_TMO], 1u); break; } } } } while (0)

struct XcdBarrier {
    unsigned* bar; unsigned x;
    volatile LAS unsigned* st;
};

__device__ __forceinline__ XcdBarrier xcd_barrier_post(unsigned* bar, volatile LAS unsigned* st) {
    XcdBarrier b; b.bar = bar; b.x = xb_xcc_id(); b.st = st;
    if (threadIdx.x == 0) (void)xb_add(&bar[XB_XCNT(b.x)], 1u);
    return b;
}
__device__ __forceinline__ void xcd_barrier_complete(unsigned* bar, unsigned x, unsigned& nloc, unsigned& nx) {
    const unsigned G = gridDim.x * gridDim.y * gridDim.z;
    unsigned sum, cnt, mine, sp = 0u;
    for (;;) {
        sum = 0u; cnt = 0u; mine = 0u;
#pragma unroll
        for (unsigned j = 0; j < 16; ++j) { const unsigned c = xb_ld(&bar[XB_XCNT(j)]); sum += c; cnt += (c > 0u) ? 1u : 0u; mine = (j == x) ? c : mine; }
        if (sum == G) break;
        __builtin_amdgcn_s_sleep(1);
        if ((++sp & 255u) == 0u) { if (xb_ld(&bar[XB_TMO])) break; if (sp > XB_SPIN_CAP) { atomicAdd(&bar[XB_TMO], 1u); break; } }
    }
    nloc = mine > 0u ? mine : 1u; nx = cnt > 0u ? cnt : 1u;
}

__device__ __forceinline__ void xcd_barrier(const XcdBarrier& b) {
    asm volatile("s_waitcnt vmcnt(0)" ::: "memory");
    __syncthreads();
    if (threadIdx.x == 0) {
        unsigned* bar = b.bar;
        __builtin_amdgcn_s_waitcnt(0);
        unsigned nloc = b.st[0], nx = b.st[1];
        if (nloc == 0u) { xcd_barrier_complete(bar, b.x, nloc, nx); b.st[0] = nloc; b.st[1] = nx; }
        const unsigned old = xb_add(&bar[XB_XSUB(b.x)], 1u);
        const unsigned gen = old / nloc;
        if (old + 1u == (gen + 1u) * nloc) {
            __builtin_amdgcn_fence(__ATOMIC_RELEASE, "agent");
            asm volatile("s_waitcnt vmcnt(0)" ::: "memory");
            const unsigned og = xb_add(&bar[XB_TOP], 1u);
            const unsigned tg = og / nx;
            if (og + 1u == (tg + 1u) * nx) xb_add(&bar[XB_TOPGEN], 1u);
            else XB_SPIN(xb_ld(&bar[XB_TOPGEN]) == tg, bar);
            __builtin_amdgcn_fence(__ATOMIC_ACQUIRE, "agent");
            xb_add(&bar[XB_XGEN(b.x)], 1u);
            asm volatile("s_waitcnt vmcnt(0)" ::: "memory");
        } else {
            XB_SPIN(xb_ld(&bar[XB_XGEN(b.x)]) == gen, bar);
            __builtin_amdgcn_fence(__ATOMIC_ACQUIRE, "agent");
            asm volatile("s_waitcnt vmcnt(0)" ::: "memory");
        }
    }
    __syncthreads();
}

struct Frame {
    LAS unsigned char* lds;
    volatile LAS unsigned* MISC;
    gu32* ctl;
    int tid, lane, wave;
    int vcu, G;
    const float *xp, *xs, *cache_k, *cache_v, *state_conv, *rel_bias, *ln1_g, *w_in, *lq1, *lk1, *lq2, *lk2, *subln_g, *w_dw, *b_dw, *cln_g, *cln_b, *w_out, *ln2_g, *w_up, *w_down, *lnf_g;
    float* out;
    bf16 *Win_t, *Wout_t, *Wup_t, *Wdn_t, *XN, *Q, *Kp, *Vp, *Kc, *Vc, *U, *AC, *H; float* ssq;
};
__device__ __forceinline__ float wave_sum(float v) {
#pragma unroll
    for (int o = 1; o < 64; o <<= 1) v += __shfl_xor(v, o);
    return v;
}
__device__ __forceinline__ void p0_transpose_item(const float* W, int K, int N, bf16* WT, LAS float* scr, int k0, int n0, int sn0, int lane, const float* kgain = nullptr) {
#pragma unroll 8
    for (int i = 0; i < 32; ++i) { const int kk = 2 * i + (lane >> 5); const float gk = kgain ? kgain[k0 + kk] : 1.0f; scr[kk * 33 + (lane & 31)] = W[(size_t)(k0 + kk) * N + sn0 + (lane & 31)] * gk; }
    LDS_WAIT(); asm volatile("" ::: "memory");
    const int c = lane & 7;
#pragma unroll
    for (int j = 0; j < 4; ++j) { const int n = (lane >> 3) + 8 * j; const LAS float* s = scr + (8 * c) * 33 + n;
        v4u o; o.x = pk2(s[0 * 33], s[1 * 33]); o.y = pk2(s[2 * 33], s[3 * 33]); o.z = pk2(s[4 * 33], s[5 * 33]); o.w = pk2(s[6 * 33], s[7 * 33]);
        *(GAS v4u*)(WT + (size_t)(n0 + n) * K + k0 + 8 * c) = o; }
    LDS_WAIT(); asm volatile("" ::: "memory");
}
__device__ __forceinline__ int win_src_col(int n0) {
    if (n0 < 1536) return n0;
    const int j = n0 - 1536, t = j >> 8, jj = j & 255;
    return jj < 128 ? 1536 + 128 * t + jj : 2048 + 128 * t + (jj - 128);
}
template <bool BF> __device__ __forceinline__ void rms_row(const float* xrow, const float* g, void* orow, int lane) {
    const GAS f32x4* xr = (const GAS f32x4*)xrow + lane; const GAS f32x4* gr = (const GAS f32x4*)g + lane;
    f32x4 v[4]; float s = 0.f;
#pragma unroll
    for (int j = 0; j < 4; ++j) { v[j] = xr[64 * j]; s += (v[j].x * v[j].x + v[j].y * v[j].y) + (v[j].z * v[j].z + v[j].w * v[j].w); }
    const float rstd = 1.0f / sqrtf(wave_sum(s) * (1.0f / 1024.0f) + EPS);
#pragma unroll
    for (int j = 0; j < 4; ++j) { const f32x4 gg = gr[64 * j]; const f32x4 y = v[j] * rstd * gg;
        if (BF) ((GAS unsigned long long*)orow)[lane + 64 * j] = (unsigned long long)pk2(y.x, y.y) | ((unsigned long long)pk2(y.z, y.w) << 32);
        else ((GAS f32x4*)orow)[lane + 64 * j] = y; }
}
__device__ __forceinline__ const float* x_row(const Frame& F, int R) { return R < pg8::PROMPT_ROWS ? F.xp + (size_t)R * DM : F.xs + (size_t)(R - pg8::PROMPT_ROWS) * DM; }

__device__ __forceinline__ void p0_prologue(Frame& F) {
    LAS float* scr = (LAS float*)(F.lds + RING_OFF + F.wave * 16384);
    const int gw = F.vcu * NWAVES + F.wave, NGW = F.G * NWAVES;
    constexpr int I_IN = (DM / 64) * (INCOLS / 32), I_OUT = (DM / 64) * (DM / 32), I_UP = (DM / 64) * (DFF / 32), I_DN = (DFF / 64) * (DM / 32);
    constexpr int NITEMS = I_IN + I_OUT + I_UP + I_DN;
    for (int it = gw; it < NITEMS; it += NGW) {
        int r = it;
        if (r < I_IN) { const int nb = INCOLS / 32, kb = r / nb, n0 = 32 * (r % nb); p0_transpose_item(F.w_in, DM, INCOLS, F.Win_t, scr, 64 * kb, n0, win_src_col(n0), F.lane); continue; } r -= I_IN;
        if (r < I_OUT) { const int nb = DM / 32, kb = r / nb, n0 = 32 * (r % nb); p0_transpose_item(F.w_out, DM, DM, F.Wout_t, scr, 64 * kb, n0, n0, F.lane); continue; } r -= I_OUT;
        if (r < I_UP) { const int nb = DFF / 32, kb = r / nb, n0 = 32 * (r % nb); p0_transpose_item(F.w_up, DM, DFF, F.Wup_t, scr, 64 * kb, n0, n0, F.lane, F.ln2_g); continue; } r -= I_UP;
        { const int nb = DM / 32, kb = r / nb, n0 = 32 * (r % nb); p0_transpose_item(F.w_down, DFF, DM, F.Wdn_t, scr, 64 * kb, n0, n0, F.lane); }
    }
    for (int R = gw; R < MROWS; R += NGW) rms_row<true>(x_row(F, R), F.ln1_g, F.XN + (size_t)R * DM, F.lane);
    const int gt = (F.vcu * NWAVES + F.wave) * 64 + F.lane, NGT = NGW * 64;
    constexpr int GPB = PAST * 512 / 8;
    for (int g = gt; g < NSEQ_S * GPB; g += NGT) { const int b = g / GPB, w = g % GPB; const size_t so = (size_t)g * 8, dof = ((size_t)b * pg8::KC_ROWS * 512) + (size_t)w * 8;
        const f32x4 a0 = *(const GAS f32x4*)(F.cache_k + so), a1 = *(const GAS f32x4*)(F.cache_k + so + 4), b0 = *(const GAS f32x4*)(F.cache_v + so), b1 = *(const GAS f32x4*)(F.cache_v + so + 4);
        v4u ko, vo; ko.x = pk2(a0.x, a0.y); ko.y = pk2(a0.z, a0.w); ko.z = pk2(a1.x, a1.y); ko.w = pk2(a1.z, a1.w); vo.x = pk2(b0.x, b0.y); vo.y = pk2(b0.z, b0.w); vo.z = pk2(b1.x, b1.y); vo.w = pk2(b1.z, b1.w);
        *(GAS v4u*)(F.Kc + dof) = ko; *(GAS v4u*)(F.Vc + dof) = vo; }
    constexpr int ZPB = 32 * 512 / 8;
    for (int g = gt; g < NSEQ_S * ZPB; g += NGT) { const int b = g / ZPB, w = g % ZPB; const size_t dof = ((size_t)b * pg8::KC_ROWS + 2080) * 512 + (size_t)w * 8; const v4u z = {0u, 0u, 0u, 0u};
        *(GAS v4u*)(F.Kc + dof) = z; *(GAS v4u*)(F.Vc + dof) = z; }
}

__device__ __forceinline__ void attn_phase(Frame& F) {
    LAS float* tab = (LAS float*)(F.lds + att::L_TAB);
    for (int i = F.tid; i < 4 * 192; i += NWAVES * 64) { const int h = i / 192, d = i % 192 - 128; tab[i] = F.rel_bias[att::t5_bucket(d) * NH + h] * LOG2E; }
    float s1 = 0.f, s2 = 0.f;
    for (int i = 0; i < 64; ++i) { s1 += F.lq1[i] * F.lk1[i]; s2 += F.lq2[i] * F.lk2[i]; }
    const float lam = expf(s1) - expf(s2) + LAM_INIT;
    __syncthreads();
    for (int pg = F.vcu; pg < 256; pg += F.G) {
        const int bh = pg >> 2, s = pg & 3, b = bh >> 2, h = bh & 3;
        for (int i = 0; i < 4; ++i) { const int qb = (i == 0) ? 15 - s : (i == 1) ? 8 + s : (i == 2) ? 7 - s : s;
            att::AUnit u; u.Q = F.Q + (size_t)(b * TP + 128 * qb) * 512; u.K = F.Kp + (size_t)b * TP * 512; u.V = F.Vp + (size_t)b * TP * 512; u.O = F.AC + (size_t)(b * TP + 128 * qb) * 1024;
            u.h = h; u.NT = 2 * qb + 2; u.nkeys = 64 * u.NT; u.qpos0 = 128 * qb; u.nrb = 4;
            att::attn_unit(u, F.lds, lam, F.subln_g); }
    }
    for (int su = F.vcu; su < NSEQ_S * NH; su += F.G) {
        const int b = su >> 2, h = su & 3;
        att::AUnit u; u.Q = F.Q + (size_t)(pg8::PROMPT_ROWS + b * TS) * 512; u.K = F.Kc + (size_t)b * pg8::KC_ROWS * 512; u.V = F.Vc + (size_t)b * pg8::KC_ROWS * 512; u.O = F.AC + (size_t)(pg8::PROMPT_ROWS + b * TS) * 1024;
        u.h = h; u.NT = 33; u.nkeys = PAST + TS; u.qpos0 = PAST; u.nrb = 1;
        att::attn_unit(u, F.lds, lam, F.subln_g);
    }
}

__device__ __forceinline__ float dpp_row_sum(float v) {
    v += __builtin_bit_cast(float, __builtin_amdgcn_update_dpp(0, __builtin_bit_cast(int, v), 0xB1, 0xF, 0xF, true));
    v += __builtin_bit_cast(float, __builtin_amdgcn_update_dpp(0, __builtin_bit_cast(int, v), 0x4E, 0xF, 0xF, true));
    v += __builtin_bit_cast(float, __builtin_amdgcn_update_dpp(0, __builtin_bit_cast(int, v), 0x141, 0xF, 0xF, true));
    v += __builtin_bit_cast(float, __builtin_amdgcn_update_dpp(0, __builtin_bit_cast(int, v), 0x140, 0xF, 0xF, true));
    return v;
}
__device__ __forceinline__ float dpp_wave_sum63(float v) {
    v = dpp_row_sum(v);
    v += __builtin_bit_cast(float, __builtin_amdgcn_update_dpp(0, __builtin_bit_cast(int, v), 0x142, 0xA, 0xF, false));
    v += __builtin_bit_cast(float, __builtin_amdgcn_update_dpp(0, __builtin_bit_cast(int, v), 0x143, 0xC, 0xF, false));
    return v;
}
template <int NPRE, bool HP> __device__ __forceinline__ void conv_load(float (&u0)[38], float (&u1)[38], const bf16* up, const float* pp) {
#pragma unroll
    for (int i = 0; i < 38; ++i) {
        if (i >= NPRE) { const unsigned v = *(const unsigned*)(up + (size_t)i * WB); u0[i] = __builtin_bit_cast(float, v << 16); u1[i] = __builtin_bit_cast(float, v & 0xffff0000u); }
        else if (HP) { const float2 v = *(const float2*)(pp + (size_t)i * WB); u0[i] = v.x; u1[i] = v.y; }
        else { u0[i] = 0.f; u1[i] = 0.f; } }
}
__device__ __forceinline__ void conv_phase(Frame& F) {
    LAS float* red = (LAS float*)(F.lds + 96 * 1024);
    LAS float* stat = red + 128;
    const int cp = F.tid & 255, rh = F.wave >> 2, c = 2 * cp;
    float w0[CW], w1[CW];
#pragma unroll
    for (int j = 0; j < CW; ++j) { const float2 ww = *(const float2*)(F.w_dw + j * WB + c); w0[j] = ww.x; w1[j] = ww.y; }
    const float2 bdw = *(const float2*)(F.b_dw + c), lg = *(const float2*)(F.cln_g + c), lb = *(const float2*)(F.cln_b + c);
    constexpr int NU_P = NSEQ_P * (TP / 16), NU_S = NSEQ_S * (TS / 16);
    for (int un = F.vcu; un < NU_P + NU_S; un += F.G) {
        int b, t0, T, rowbase; const float* pre = nullptr; float* ost;
        if (un < NU_P) { b = un / (TP / 16); t0 = (un % (TP / 16)) * 16; T = TP; rowbase = b * TP; ost = F.out + O_CP + (size_t)b * CPAD * WB; }
        else { const int s = un - NU_P; b = s >> 1; t0 = (s & 1) * 16; T = TS; rowbase = pg8::PROMPT_ROWS + b * TS; pre = F.state_conv + (size_t)b * CPAD * WB; ost = F.out + O_CS + (size_t)b * CPAD * WB; }
        const int tb = t0 + 8 * rh;
        float u0[38], u1[38];
        { const int npre = tb >= CPAD ? 0 : CPAD - tb;
            const bf16* up = F.U + (size_t)(rowbase + tb - CPAD) * WB + c; const float* pp = pre ? pre + (size_t)tb * WB + c : nullptr;
            if (npre == 0) conv_load<0, false>(u0, u1, up, pp);
            else if (pre) { if (npre == 30) conv_load<30, true>(u0, u1, up, pp); else if (npre == 22) conv_load<22, true>(u0, u1, up, pp); else if (npre == 14) conv_load<14, true>(u0, u1, up, pp); else conv_load<6, true>(u0, u1, up, pp); }
            else { if (npre == 30) conv_load<30, false>(u0, u1, up, pp); else if (npre == 22) conv_load<22, false>(u0, u1, up, pp); else if (npre == 14) conv_load<14, false>(u0, u1, up, pp); else conv_load<6, false>(u0, u1, up, pp); } }
        float y0[8], y1[8];
#pragma unroll
        for (int i = 0; i < 8; ++i) { float a0 = bdw.x, a1 = bdw.y;
#pragma unroll
            for (int j = 0; j < CW; ++j) { a0 += w0[j] * u0[i + j]; a1 += w1[j] * u1[i + j]; }
            y0[i] = a0; y1[i] = a1; }
#pragma unroll
        for (int i = 0; i < 8; ++i) { const float s1 = dpp_wave_sum63(y0[i] + y1[i]), s2 = dpp_wave_sum63(y0[i] * y0[i] + y1[i] * y1[i]);
            if (F.lane == 63) { red[F.wave * 16 + 2 * i] = s1; red[F.wave * 16 + 2 * i + 1] = s2; } }
        __syncthreads();
        if (F.tid < 16) { const int r = F.tid, h = r >> 3, i = r & 7; float a = 0.f, q = 0.f;
#pragma unroll
            for (int ww = 0; ww < 4; ++ww) { a += red[(4 * h + ww) * 16 + 2 * i]; q += red[(4 * h + ww) * 16 + 2 * i + 1]; }
            const float mean = a * (1.0f / WB), var = fmaxf(q * (1.0f / WB) - mean * mean, 0.f);
            stat[2 * r] = mean; stat[2 * r + 1] = 1.0f / sqrtf(var + EPS); }
        __syncthreads();
#pragma unroll
        for (int i = 0; i < 8; ++i) { const float mean = stat[2 * (8 * rh + i)], rstd = stat[2 * (8 * rh + i) + 1];
            float v0 = (y0[i] - mean) * rstd * lg.x + lb.x, v1 = (y1[i] - mean) * rstd * lg.y + lb.y; v0 = v0 * pg8::sigmoidf_fast(v0); v1 = v1 * pg8::sigmoidf_fast(v1);
            *(unsigned*)(F.AC + (size_t)(rowbase + tb + i) * 1024 + 512 + c) = pk2(v0, v1);
            const int t = tb + i; if (t >= T - CPAD) *(float2*)(ost + (size_t)(t - (T - CPAD)) * WB + c) = make_float2(u0[CPAD + i], u1[CPAD + i]); }
        __syncthreads();
    }
}

#ifndef MK_N_LAUNCHES
#define MK_N_LAUNCHES 1
#endif
constexpr int N_PHASES = 8;
constexpr int N_LAUNCHES = MK_N_LAUNCHES;
struct Args { const float* in[22]; float* out; unsigned char* ws; int ph_lo, ph_hi, li, pad; };
__global__ void __launch_bounds__(NWAVES * 64, 2) fwd_kernel(Args args) {
    extern __shared__ __attribute__((aligned(16))) unsigned char lds[];
    Frame F;
    F.lds = (LAS unsigned char*)lds;
    F.MISC = (volatile LAS unsigned*)(F.lds + MISC_OFF);
    F.tid = threadIdx.x; F.lane = F.tid & 63; F.wave = __builtin_amdgcn_readfirstlane(F.tid >> 6);
    F.G = gridDim.x; { const int bx = blockIdx.x; F.vcu = (F.G % 8 == 0) ? (bx % 8) * (F.G / 8) + bx / 8 : bx; }
    unsigned char* ws = args.ws;
    F.ctl = (gu32*)(ws + WS_CTL);
    F.xp = args.in[0]; F.xs = args.in[1]; F.cache_k = args.in[2]; F.cache_v = args.in[3]; F.state_conv = args.in[4]; F.rel_bias = args.in[5]; F.ln1_g = args.in[6]; F.w_in = args.in[7];
    F.lq1 = args.in[8]; F.lk1 = args.in[9]; F.lq2 = args.in[10]; F.lk2 = args.in[11]; F.subln_g = args.in[12]; F.w_dw = args.in[13]; F.b_dw = args.in[14]; F.cln_g = args.in[15]; F.cln_b = args.in[16];
    F.w_out = args.in[17]; F.ln2_g = args.in[18]; F.w_up = args.in[19]; F.w_down = args.in[20]; F.lnf_g = args.in[21]; F.out = args.out;
    F.Win_t = (bf16*)(ws + WS_WIN); F.Wout_t = (bf16*)(ws + WS_WOUT); F.Wup_t = (bf16*)(ws + WS_WUP); F.Wdn_t = (bf16*)(ws + WS_WDN); F.XN = (bf16*)(ws + WS_XN);
    F.Q = (bf16*)(ws + WS_Q); F.Kp = (bf16*)(ws + WS_KP); F.Vp = (bf16*)(ws + WS_VP); F.Kc = (bf16*)(ws + WS_KC); F.Vc = (bf16*)(ws + WS_VC); F.U = (bf16*)(ws + WS_U); F.AC = (bf16*)(ws + WS_AC); F.H = (bf16*)(ws + WS_H); F.ssq = (float*)(ws + WS_SSQ);
    for (int u = F.tid; u < (LDS_BYTES - LDSCTL_OFF) / 4; u += NWAVES * 64) ((LAS unsigned*)(F.lds + LDSCTL_OFF))[u] = 0u;
    __syncthreads();
    XcdBarrier bar; bar.bar = (unsigned*)(F.ctl + CW_BAR); bar.x = 0; bar.st = nullptr;
    if (N_LAUNCHES == 1) bar = xcd_barrier_post((unsigned*)(F.ctl + CW_BAR), F.MISC + 8);
    const int lo = args.ph_lo, hi = args.ph_hi;
#define IN(k) (lo <= (k) && (k) < hi)
#define SEAM(k) do { if (IN(k) && IN((k) + 1)) xcd_barrier(bar); } while (0)
#ifndef REP_PHASE
#define REP_PHASE -1
#endif
#ifndef REP_N
#define REP_N 1
#endif
#define NREP(k) (((k) == REP_PHASE) ? 1 + REP_N : 1)
    const float QSCALE = 0.125f * LOG2E;

    if (IN(0)) for (int rep = 0; rep < NREP(0); ++rep) { p0_prologue(F); SEAM(0); }
    if (IN(1)) for (int rep = 0; rep < NREP(1); ++rep) {
        pg8::Gemm g{F.XN, F.Win_t, MROWS, INCOLS, DM}; pg8::StaticOrder S; S.init(MROWS, INCOLS, F.G, (int)blockIdx.x);
        pg8::EpiProj E{F.Q, F.Kp, F.Vp, F.Kc, F.Vc, F.U, F.out + O_KP, F.out + O_VP, F.out + O_KS, F.out + O_VS, QSCALE};
        pg8::gemm_phase<pg8::EpiProj, pg8::StaticOrder, true, true>(F.lds + RING_OFF, g, S, E);
        SEAM(1);
    }
    if (IN(2)) { for (int rep = 0; rep < NREP(2); ++rep) attn_phase(F); for (int rep = 0; rep < NREP(8); ++rep) conv_phase(F); SEAM(2); }
    if (IN(3)) for (int rep = 0; rep < NREP(3); ++rep) {
        pg8::Gemm g{F.AC, F.Wout_t, MROWS, DM, DM}; pg8::StaticOrder S; S.init(MROWS, DM, F.G, (int)blockIdx.x);
        pg8::EpiRes1 E{F.xp, F.xs, F.XN, F.ssq};
        pg8::gemm_phase<pg8::EpiRes1, pg8::StaticOrder, true, true>(F.lds + RING_OFF, g, S, E);
        SEAM(3);
    }
    if (IN(5)) for (int rep = 0; rep < NREP(5); ++rep) {
        pg8::Gemm g{F.XN, F.Wup_t, MROWS, DFF, DM}; pg8::StaticOrder S; S.init(MROWS, DFF, F.G, (int)blockIdx.x);
        pg8::EpiRelu2 E{F.H, DFF, F.ssq, EPS};
        pg8::gemm_phase<pg8::EpiRelu2, pg8::StaticOrder, true, true>(F.lds + RING_OFF, g, S, E);
        SEAM(5);
    }
    if (IN(6)) {
        pg8::Gemm g{F.H, F.Wdn_t, MROWS, DM, DFF}; pg8::StaticOrder S; S.init(MROWS, DM, F.G, (int)blockIdx.x);
        pg8::EpiRes2 E{F.XN, F.out};
        pg8::gemm_phase<pg8::EpiRes2, pg8::StaticOrder, true, true>(F.lds + RING_OFF, g, S, E);
        SEAM(6);
    }
    if (IN(7)) {
        const int gw = F.vcu * NWAVES + F.wave, NGW = F.G * NWAVES;
        for (int R = gw; R < MROWS; R += NGW) rms_row<false>(F.out + (size_t)R * DM, F.lnf_g, F.out + (size_t)R * DM, F.lane);
    }
#undef IN
#undef SEAM
}

extern "C" void kernel_launch(void* const* d_in, const int* in_sizes, int n_in, void* d_out, int out_size, void* d_ws, size_t ws_size, hipStream_t stream) {
    static int grid = 0;
    if (grid == 0) {
        if (n_in != 22 || (size_t)out_size != O_END || ws_size < WS_END) { fprintf(stderr, "kernel_launch: unexpected shapes: n_in %d out %d ws %zu; nothing launched\n", n_in, out_size, ws_size); grid = -1; return; }
        int dev = 0, cus = 0, per_cu = 0;
        if (hipGetDevice(&dev) != hipSuccess || hipDeviceGetAttribute(&cus, hipDeviceAttributeMultiprocessorCount, dev) != hipSuccess) { fprintf(stderr, "kernel_launch: device query failed\n"); grid = -1; return; }
        if (hipFuncSetAttribute((const void*)fwd_kernel, hipFuncAttributeMaxDynamicSharedMemorySize, LDS_BYTES) != hipSuccess) { fprintf(stderr, "kernel_launch: hipFuncSetAttribute failed\n"); grid = -1; return; }
        if (hipOccupancyMaxActiveBlocksPerMultiprocessor(&per_cu, (const void*)fwd_kernel, NWAVES * 64, LDS_BYTES) != hipSuccess || per_cu < 1) { fprintf(stderr, "kernel_launch: occupancy query reports %d blocks per CU\n", per_cu); }
        (void)hipGetLastError();
        grid = cus;
    }
    if (grid < 0) return;
    (void)hipMemsetAsync((char*)d_ws + WS_CTL, 0, CTL_ZERO_BYTES, stream);
    Args a{};
    for (int i = 0; i < 22; ++i) a.in[i] = (const float*)d_in[i];
    a.out = (float*)d_out; a.ws = (unsigned char*)d_ws;
    for (int li = 0; li < N_LAUNCHES; ++li) {
        a.ph_lo = (N_LAUNCHES == 1) ? 0 : li; a.ph_hi = (N_LAUNCHES == 1) ? N_PHASES : li + 1; a.li = li;
        hipLaunchKernelGGL(fwd_kernel, dim3(grid), dim3(NWAVES * 64), LDS_BYTES, stream, a);
    }
}
```

```cpp
#include <hip/hip_runtime.h>
#include <hip/hip_bf16.h>
#include <cstdio>
#include <cstdint>
#include <cmath>
namespace pg8 {
#define PG8_LAS __attribute__((address_space(3)))
typedef unsigned short bf16_t;
typedef short bf16x8 __attribute__((ext_vector_type(8)));
typedef float f32x4 __attribute__((ext_vector_type(4)));
typedef unsigned u32x4 __attribute__((ext_vector_type(4)));
constexpr int BM = 256, BK = 64, HALF = 128, HTB = HALF * BK * 2  , STAGE_BYTES = 8 * HTB, NXCD = 8, WGM = 8;

__host__ __device__ __forceinline__ int lds_byte(int r, int c) { const int st = (r >> 4) * 2 + (c >> 5), rr = r & 15, cc = c & 31, ob = rr * 64 + cc * 2; return st * 1024 + (ob ^ (((ob >> 9) & 1) << 5)); }
__host__ __device__ __forceinline__ void stage_rc(int b, int& R, int& C) { const int st = b / 1024, sb = b % 1024, swz = sb ^ (((sb >> 9) & 1) << 5); R = (st >> 1) * 16 + swz / 64; C = (st & 1) * 32 + (swz % 64) / 2; }
__host__ __device__ __forceinline__ int perm32(int rho) { const int n = rho >> 4, i = rho & 15; return 8 * (i >> 2) + 4 * n + (i & 3); }

struct Unit { int pm, pn; };
struct Gemm { const bf16_t* A; const bf16_t* Bt; int M, N, K; };

struct StaticOrder {
    int nM, nN, nwg, G, c;
    __host__ __device__ void init(int M, int N, int G_, int c_) { nM = M / BM; nN = N / BM; nwg = nM * nN; G = G_; c = c_; }
    __host__ __device__ bool next(int i, Unit& u) const {
        const long L = (long)i * G + c; if (L >= nwg) return false;
        int wgid = (int)L; { const int q = nwg / NXCD, r = nwg % NXCD, xcd = wgid % NXCD, off = wgid / NXCD; wgid = (xcd < r ? xcd * (q + 1) : r * (q + 1) + (xcd - r) * q) + off; }
        const int nig = WGM * nN, gid = wgid / nig, fm = gid * WGM, gsz = (nM - fm) < WGM ? (nM - fm) : WGM;
        u.pm = fm + ((wgid % nig) % gsz); u.pn = (wgid % nig) / gsz; return true;
    }
    __device__ __forceinline__ void a_ready(const Unit&) const {}
    __device__ __forceinline__ void done(const Unit&) const {}
};


__device__ __forceinline__ unsigned cvt_pk_bf16(float lo, float hi) { unsigned r; asm volatile("v_cvt_pk_bf16_f32 %0, %1, %2" : "=v"(r) : "v"(lo), "v"(hi)); return r; }
__device__ __forceinline__ u32x4 pack8(const f32x4 v0, const f32x4 v1) { u32x4 w; w.x = cvt_pk_bf16(v0[0], v0[1]); w.y = cvt_pk_bf16(v0[2], v0[3]); w.z = cvt_pk_bf16(v1[0], v1[1]); w.w = cvt_pk_bf16(v1[2], v1[3]); return w; }
__device__ __forceinline__ float sigmoidf_fast(float g) { return __builtin_amdgcn_rcpf(1.0f + __builtin_amdgcn_exp2f(-1.4426950408889634f * g)); }

constexpr int PROMPT_ROWS = 32768;
constexpr int KC_ROWS = 2112;

struct EpiProj {
    static constexpr bool PERM = true, AFTER_DRAIN = false;
    bf16_t *Q, *Kp, *Vp, *Kc, *Vc, *U; float *okp, *ovp, *oks, *ovs; float qscale;
    __device__ __forceinline__ void operator()(const f32x4 (&acc)[2][2][4][2], const Unit& u, int wr, int wc, int fr, int fq) const {
        const int pn = u.pn; const bool sample = u.pm >= PROMPT_ROWS / BM;
        const int row0 = u.pm * BM + wr * 64 + fr, cl = wc * 32 + 8 * fq;
        if (pn < 2) {
#pragma unroll
            for (int ai = 0; ai < 2; ++ai)
#pragma unroll
                for (int m = 0; m < 4; ++m) { bf16_t* rp = Q + (size_t)(row0 + ai * HALF + m * 16) * 512 + pn * 256 + cl;
#pragma unroll
                    for (int bj = 0; bj < 2; ++bj) *(u32x4*)(rp + bj * HALF) = pack8(acc[ai][bj][m][0] * qscale, acc[ai][bj][m][1] * qscale); }
        } else if (pn < 6) {
            const bool isV = pn >= 4; const int c0 = (pn & 1) * 256 + cl;
#pragma unroll
            for (int ai = 0; ai < 2; ++ai)
#pragma unroll
                for (int m = 0; m < 4; ++m) { const int R = row0 + ai * HALF + m * 16;
                    if (!sample) { bf16_t* bp = (isV ? Vp : Kp) + (size_t)R * 512 + c0; float* fp = (isV ? ovp : okp) + (size_t)R * 512 + c0;
#pragma unroll
                        for (int bj = 0; bj < 2; ++bj) { const f32x4 v0 = acc[ai][bj][m][0], v1 = acc[ai][bj][m][1];
                            *(u32x4*)(bp + bj * HALF) = pack8(v0, v1); *(f32x4*)(fp + bj * HALF) = v0; *(f32x4*)(fp + bj * HALF + 4) = v1; } }
                    else { float* fp = (isV ? ovs : oks) + (size_t)(R - PROMPT_ROWS) * 512 + c0;
#pragma unroll
                        for (int bj = 0; bj < 2; ++bj) { *(f32x4*)(fp + bj * HALF) = acc[ai][bj][m][0]; *(f32x4*)(fp + bj * HALF + 4) = acc[ai][bj][m][1]; } } }
        } else {
            const int c0 = (pn - 6) * 128 + cl;
#pragma unroll
            for (int ai = 0; ai < 2; ++ai)
#pragma unroll
                for (int m = 0; m < 4; ++m) { const int R = row0 + ai * HALF + m * 16; f32x4 o0, o1;
#pragma unroll
                    for (int i = 0; i < 4; ++i) { o0[i] = acc[ai][0][m][0][i] * sigmoidf_fast(acc[ai][1][m][0][i]); o1[i] = acc[ai][0][m][1][i] * sigmoidf_fast(acc[ai][1][m][1][i]); }
                    *(u32x4*)(U + (size_t)R * 512 + c0) = pack8(o0, o1); }
        }
    }
};
struct EpiRes1 {
    static constexpr bool PERM = true, AFTER_DRAIN = false;
    const float* resP; const float* resS; bf16_t* XB; float* ssq;
    __device__ __forceinline__ void operator()(const f32x4 (&acc)[2][2][4][2], const Unit& u, int wr, int wc, int fr, int fq) const {
        const int row0 = u.pm * BM + wr * 64 + fr, col0 = u.pn * BM + wc * 32 + 8 * fq;
        const float* rbase = (u.pm >= PROMPT_ROWS / BM) ? resS - (size_t)PROMPT_ROWS * 1024 : resP;
#pragma unroll
        for (int ai = 0; ai < 2; ++ai)
#pragma unroll
            for (int m = 0; m < 4; ++m) { const int R = row0 + ai * HALF + m * 16; const size_t off = (size_t)R * 1024 + col0; float q = 0.f;
#pragma unroll
                for (int bj = 0; bj < 2; ++bj) { const f32x4 r0 = *(const f32x4*)(rbase + off + bj * HALF), r1 = *(const f32x4*)(rbase + off + bj * HALF + 4);
                    const f32x4 v0 = r0 + acc[ai][bj][m][0], v1 = r1 + acc[ai][bj][m][1];
                    q += (v0[0] * v0[0] + v0[1] * v0[1]) + (v0[2] * v0[2] + v0[3] * v0[3]) + (v1[0] * v1[0] + v1[1] * v1[1]) + (v1[2] * v1[2] + v1[3] * v1[3]);
                    *(u32x4*)(XB + off + bj * HALF) = pack8(v0, v1); }
                q += __shfl_xor(q, 16); q += __shfl_xor(q, 32);
                if (fq == 0) ssq[(size_t)R * 16 + u.pn * 4 + wc] = q; }
    }
};
struct EpiRelu2 {
    static constexpr bool PERM = true, AFTER_DRAIN = false;
    bf16_t* O; int ldc; const float* ssq; float eps;
    __device__ __forceinline__ void operator()(const f32x4 (&acc)[2][2][4][2], const Unit& u, int wr, int wc, int fr, int fq) const {
        const int row0 = u.pm * BM + wr * 64 + fr, col0 = u.pn * BM + wc * 32 + 8 * fq;
#pragma unroll
        for (int ai = 0; ai < 2; ++ai)
#pragma unroll
            for (int m = 0; m < 4; ++m) { const int R = row0 + ai * HALF + m * 16; const f32x4* sp = (const f32x4*)(ssq + (size_t)R * 16);
                const f32x4 s0 = sp[0], s1 = sp[1], s2 = sp[2], s3 = sp[3]; const f32x4 st = (s0 + s1) + (s2 + s3);
                const float rstd = 1.0f / sqrtf(((st[0] + st[1]) + (st[2] + st[3])) * (1.0f / 1024.0f) + eps);
                bf16_t* rp = O + (size_t)R * ldc + col0;
#pragma unroll
                for (int bj = 0; bj < 2; ++bj) { f32x4 v0 = acc[ai][bj][m][0], v1 = acc[ai][bj][m][1];
#pragma unroll
                    for (int i = 0; i < 4; ++i) { const float a = fmaxf(v0[i], 0.f) * rstd, b = fmaxf(v1[i], 0.f) * rstd; v0[i] = a * a; v1[i] = b * b; }
                    *(u32x4*)(rp + bj * HALF) = pack8(v0, v1); } }
    }
};
struct EpiRes2 {
    static constexpr bool PERM = true, AFTER_DRAIN = false;
    const bf16_t* XB; float* out;
    __device__ __forceinline__ void operator()(const f32x4 (&acc)[2][2][4][2], const Unit& u, int wr, int wc, int fr, int fq) const {
        const int row0 = u.pm * BM + wr * 64 + fr, col0 = u.pn * BM + wc * 32 + 8 * fq;
#pragma unroll
        for (int ai = 0; ai < 2; ++ai)
#pragma unroll
            for (int m = 0; m < 4; ++m) { const size_t off = (size_t)(row0 + ai * HALF + m * 16) * 1024 + col0;
#pragma unroll
                for (int bj = 0; bj < 2; ++bj) { const u32x4 w = *(const u32x4*)(XB + off + bj * HALF); f32x4 r0, r1;
                    r0[0] = __builtin_bit_cast(float, w.x << 16); r0[1] = __builtin_bit_cast(float, w.x & 0xffff0000u); r0[2] = __builtin_bit_cast(float, w.y << 16); r0[3] = __builtin_bit_cast(float, w.y & 0xffff0000u);
                    r1[0] = __builtin_bit_cast(float, w.z << 16); r1[1] = __builtin_bit_cast(float, w.z & 0xffff0000u); r1[2] = __builtin_bit_cast(float, w.w << 16); r1[3] = __builtin_bit_cast(float, w.w & 0xffff0000u);
                    *(f32x4*)(out + off + bj * HALF) = r0 + acc[ai][bj][m][0]; *(f32x4*)(out + off + bj * HALF + 4) = r1 + acc[ai][bj][m][1]; } }
    }
};

template <class Epi, class Sched, bool ALIGN_EPI = false, bool SP2 = false>
__device__ __forceinline__ void gemm_phase(PG8_LAS unsigned char* lds, const Gemm g, const Sched& S, const Epi& E) {
    const int tid = threadIdx.x, wid = __builtin_amdgcn_readfirstlane(tid >> 6), lane = tid & 63, wr = wid >> 2, wc = wid & 3, fr = lane & 15, fq = lane >> 4;
    const int K = g.K, nt = K / BK;
    unsigned voffA[2], voffB[2];
#pragma unroll
    for (int i = 0; i < 2; ++i) { int R, C; stage_rc(tid * 16 + i * 8192, R, C); const int Rb = Epi::PERM ? ((R & ~31) + perm32(R & 31)) : R;
        voffA[i] = (unsigned)(R * K + C) * 2u; voffB[i] = (unsigned)(Rb * K + C) * 2u; }
    const size_t kstep = (size_t)(BK * 2);
    const size_t hstep = (size_t)HALF * K * 2;
    const size_t tstep = 2 * hstep;
    const unsigned ldsw = (unsigned)wid * 1024u;
    const int aoff = lds_byte(wr * 64 + fr, fq * 8), boff = lds_byte(wc * 32 + fr, fq * 8);
#define PG8_SA(b, h) (((b) * 2 + (h)) * HTB)
#define PG8_SB(b, h) ((4 + (b) * 2 + (h)) * HTB)
#define PG8_STAGE(bufoff, gbase, voff) do { _Pragma("unroll") for (int _i = 0; _i < 2; ++_i) \
        __builtin_amdgcn_global_load_lds((const unsigned*)((const char*)(gbase) + (voff)[_i]), (PG8_LAS unsigned*)(lds + (bufoff) + ldsw + _i * 8192), 16, 0, 0); } while (0)
#define PG8_LDA(dst, b, h) do { _Pragma("unroll") for (int m = 0; m < 4; ++m) _Pragma("unroll") for (int k = 0; k < 2; ++k) dst[m][k] = *(const PG8_LAS bf16x8*)(lds + PG8_SA(b, h) + aoff + m * 2048 + k * 1024); } while (0)
#define PG8_LDB(dst, b, h) do { _Pragma("unroll") for (int n = 0; n < 2; ++n) _Pragma("unroll") for (int k = 0; k < 2; ++k) dst[n][k] = *(const PG8_LAS bf16x8*)(lds + PG8_SB(b, h) + boff + n * 2048 + k * 1024); } while (0)
#define PG8_MMA(ai, bj, At, Bt) do { __builtin_amdgcn_s_setprio(1); _Pragma("unroll") for (int m = 0; m < 4; ++m) _Pragma("unroll") for (int n = 0; n < 2; ++n) _Pragma("unroll") for (int k = 0; k < 2; ++k) \
        acc[ai][bj][m][n] = __builtin_amdgcn_mfma_f32_16x16x32_bf16(Bt[n][k], At[m][k], acc[ai][bj][m][n], 0, 0, 0); __builtin_amdgcn_s_setprio(0); } while (0)
#define PG8_WAIT_V(n) asm volatile("s_waitcnt vmcnt(" #n ")" ::: "memory")
#define PG8_WAIT_L(n) asm volatile("s_waitcnt lgkmcnt(" #n ")" ::: "memory")
#define PG8_BAR __builtin_amdgcn_s_barrier()
#define PG8_SCHED __builtin_amdgcn_sched_barrier(0)
    Unit cur, nxt; int ui = 0;
    if (!S.next(0, cur)) return;
    f32x4 acc[2][2][4][2];
#pragma unroll
    for (int a = 0; a < 2; ++a)
#pragma unroll
        for (int b = 0; b < 2; ++b)
#pragma unroll
            for (int m = 0; m < 4; ++m)
#pragma unroll
                for (int n = 0; n < 2; ++n) acc[a][b][m][n] = (f32x4){0.f, 0.f, 0.f, 0.f};
    bf16x8 At[4][2], B0[2][2], B1[2][2];
    const char* cA = (const char*)g.A + (size_t)cur.pm * tstep; const char* cB = (const char*)g.Bt + (size_t)cur.pn * tstep;
    S.a_ready(cur);
    if constexpr (SP2) {
        PG8_STAGE(PG8_SB(0, 0), cB, voffB); PG8_STAGE(PG8_SB(0, 1), cB + hstep, voffB); PG8_STAGE(PG8_SA(0, 0), cA, voffA); PG8_STAGE(PG8_SA(0, 1), cA + hstep, voffA);
        if (wr == 1) PG8_BAR;
        PG8_WAIT_V(2); PG8_BAR;
        PG8_STAGE(PG8_SB(1, 0), cB + kstep, voffB); PG8_STAGE(PG8_SA(1, 0), cA + kstep, voffA); PG8_STAGE(PG8_SB(1, 1), cB + hstep + kstep, voffB);
        PG8_WAIT_V(6); PG8_BAR;
    } else {
        PG8_STAGE(PG8_SB(0, 0), cB, voffB); PG8_STAGE(PG8_SA(0, 0), cA, voffA); PG8_STAGE(PG8_SB(0, 1), cB + hstep, voffB); PG8_STAGE(PG8_SA(0, 1), cA + hstep, voffA);
        if (wr == 1) PG8_BAR;
        PG8_WAIT_V(4); PG8_BAR;
        PG8_STAGE(PG8_SB(1, 0), cB + kstep, voffB); PG8_STAGE(PG8_SA(1, 0), cA + kstep, voffA); PG8_STAGE(PG8_SB(1, 1), cB + hstep + kstep, voffB);
        PG8_WAIT_V(6); PG8_BAR;
    }
    for (;;) {
        const bool has_next = S.next(ui + 1, nxt);
        const char* nA = has_next ? (const char*)g.A + (size_t)nxt.pm * tstep : cA; const char* nB = has_next ? (const char*)g.Bt + (size_t)nxt.pn * tstep : cB;
        for (int t = 0; t < nt; t += 2) {
            const bool last = (t == nt - 2);
            const char* a1 = cA + (size_t)(t + 1) * kstep;
            const char* a2 = last ? nA : cA + (size_t)(t + 2) * kstep; const char* b2 = last ? nB : cB + (size_t)(t + 2) * kstep;
            const char* a3 = a2 + kstep; const char* b3 = b2 + kstep;
            if (last && has_next) S.a_ready(nxt);
            if constexpr (SP2) {
            PG8_LDB(B0, 0, 0); PG8_LDB(B1, 0, 1); PG8_SCHED; PG8_LDA(At, 0, 0); PG8_STAGE(PG8_SA(1, 1), a1 + hstep, voffA);
            PG8_WAIT_V(8); PG8_WAIT_L(0); PG8_BAR; PG8_MMA(0, 0, At, B0); PG8_MMA(0, 1, At, B1); PG8_BAR; PG8_SCHED;
            PG8_LDA(At, 0, 1); PG8_STAGE(PG8_SB(0, 0), b2, voffB); PG8_STAGE(PG8_SB(0, 1), b2 + hstep, voffB); PG8_STAGE(PG8_SA(0, 0), a2, voffA);
            PG8_WAIT_V(8); PG8_WAIT_L(0); PG8_BAR; PG8_MMA(1, 0, At, B0); PG8_MMA(1, 1, At, B1); PG8_BAR; PG8_SCHED;
            PG8_LDB(B0, 1, 0); PG8_LDB(B1, 1, 1); PG8_SCHED; PG8_LDA(At, 1, 0); PG8_STAGE(PG8_SA(0, 1), a2 + hstep, voffA);
            PG8_WAIT_V(8); PG8_WAIT_L(0); PG8_BAR; PG8_MMA(0, 0, At, B0); PG8_MMA(0, 1, At, B1); PG8_BAR; PG8_SCHED;
            PG8_LDA(At, 1, 1); PG8_STAGE(PG8_SB(1, 0), b3, voffB); PG8_STAGE(PG8_SB(1, 1), b3 + hstep, voffB); PG8_STAGE(PG8_SA(1, 0), a3, voffA);
            PG8_WAIT_V(8); PG8_WAIT_L(0); PG8_BAR; PG8_MMA(1, 0, At, B0); PG8_MMA(1, 1, At, B1); PG8_BAR; PG8_SCHED;
            } else {
            PG8_LDB(B0, 0, 0); PG8_SCHED; PG8_LDA(At, 0, 0); PG8_STAGE(PG8_SA(1, 1), a1 + hstep, voffA);
            PG8_WAIT_L(8); PG8_BAR; PG8_WAIT_L(0); PG8_MMA(0, 0, At, B0); PG8_BAR; PG8_SCHED;
            PG8_LDB(B1, 0, 1); PG8_STAGE(PG8_SB(0, 0), b2, voffB);
            PG8_BAR; PG8_WAIT_L(0); PG8_MMA(0, 1, At, B1); PG8_BAR;
            PG8_LDA(At, 0, 1); PG8_STAGE(PG8_SA(0, 0), a2, voffA);
            PG8_BAR; PG8_WAIT_L(0); PG8_MMA(1, 0, At, B0); PG8_BAR; PG8_SCHED;
            PG8_STAGE(PG8_SB(0, 1), b2 + hstep, voffB);
            PG8_WAIT_V(6); PG8_BAR; PG8_MMA(1, 1, At, B1); PG8_BAR;
            PG8_LDB(B0, 1, 0); PG8_SCHED; PG8_LDA(At, 1, 0); PG8_STAGE(PG8_SA(0, 1), a2 + hstep, voffA);
            PG8_WAIT_L(8); PG8_BAR; PG8_WAIT_L(0); PG8_MMA(0, 0, At, B0); PG8_BAR; PG8_SCHED;
            PG8_LDB(B1, 1, 1); PG8_STAGE(PG8_SB(1, 0), b3, voffB);
            PG8_BAR; PG8_WAIT_L(0); PG8_MMA(0, 1, At, B1); PG8_BAR;
            PG8_LDA(At, 1, 1); PG8_STAGE(PG8_SA(1, 0), a3, voffA);
            PG8_BAR; PG8_WAIT_L(0); PG8_MMA(1, 0, At, B0); PG8_BAR; PG8_SCHED;
            PG8_STAGE(PG8_SB(1, 1), b3 + hstep, voffB);
            PG8_WAIT_V(6); PG8_BAR; PG8_MMA(1, 1, At, B1); PG8_BAR;
            }
        }
        if constexpr (ALIGN_EPI) { if (wr == 0) PG8_BAR; }
        if constexpr (!Epi::AFTER_DRAIN) { E(acc, cur, wr, wc, fr, fq); S.done(cur); }
        if (!has_next) break;
#pragma unroll
        for (int a = 0; a < 2; ++a)
#pragma unroll
            for (int b = 0; b < 2; ++b)
#pragma unroll
                for (int m = 0; m < 4; ++m)
#pragma unroll
                    for (int n = 0; n < 2; ++n) acc[a][b][m][n] = (f32x4){0.f, 0.f, 0.f, 0.f};
        cur = nxt; cA = nA; cB = nB; ++ui;
        if constexpr (ALIGN_EPI) { if (wr == 1) PG8_BAR; }
    }
    PG8_WAIT_V(0);
    if constexpr (!ALIGN_EPI) { if (wr == 0) PG8_BAR; }
    PG8_BAR;
    if constexpr (Epi::AFTER_DRAIN) { E.fused(acc, cur, wr, wc, fr, fq, lds, wid, lane); S.done(cur); }
#undef PG8_SA
#undef PG8_SB
#undef PG8_STAGE
#undef PG8_LDA
#undef PG8_LDB
#undef PG8_MMA
#undef PG8_WAIT_V
#undef PG8_WAIT_L
#undef PG8_BAR
#undef PG8_SCHED
}
}

constexpr int DM = 1024, NSEQ_P = 16, TP = 2048, NSEQ_S = 32, TS = 32, PAST = 2048;
constexpr int MROWS = NSEQ_P * TP + NSEQ_S * TS;
constexpr int NH = 4, INCOLS = 2560, DFF = 4096, CW = 31, CPAD = 30, WB = 512;
constexpr float EPS = 1e-6f, LAM_INIT = 0.2f;
constexpr float LOG2E = 1.4426950408889634f;
constexpr size_t O_YP = 0, O_YS = (size_t)NSEQ_P * TP * DM, O_KP = O_YS + (size_t)NSEQ_S * TS * DM, O_VP = O_KP + (size_t)NSEQ_P * TP * 512,
                 O_CP = O_VP + (size_t)NSEQ_P * TP * 512, O_KS = O_CP + (size_t)NSEQ_P * CPAD * WB, O_VS = O_KS + (size_t)NSEQ_S * TS * 512,
                 O_CS = O_VS + (size_t)NSEQ_S * TS * 512, O_END = O_CS + (size_t)NSEQ_S * CPAD * WB;
static_assert(O_END == 69943296, "output size");
constexpr size_t MiB = 1u << 20;
constexpr size_t WS_CTL = 0, CTL_ZERO_BYTES = 1 * MiB;
constexpr size_t WS_SSQ = 1 * MiB + 512 * 1024;
constexpr size_t WS_WIN = 4 * MiB, WS_WOUT = 9 * MiB, WS_WUP = 11 * MiB, WS_WDN = 19 * MiB;
constexpr size_t WS_XN = 27 * MiB;
constexpr size_t WS_H = 93 * MiB;
constexpr size_t WS_Q = 93 * MiB, WS_KP = 126 * MiB, WS_VP = 158 * MiB, WS_KC = 190 * MiB, WS_VC = 256 * MiB, WS_U = 322 * MiB, WS_AC = 355 * MiB, WS_END = 421 * MiB;
static_assert(WS_SSQ + (size_t)MROWS * 16 * 4 <= WS_WIN && WS_WDN + (size_t)DM * DFF * 2 <= WS_XN && WS_XN + (size_t)MROWS * DM * 2 <= WS_H && WS_H + (size_t)MROWS * DFF * 2 <= WS_END && WS_KC + (size_t)NSEQ_S * pg8::KC_ROWS * 512 * 2 <= WS_VC && WS_VC + (size_t)NSEQ_S * pg8::KC_ROWS * 512 * 2 <= WS_U && WS_U + (size_t)MROWS * 512 * 2 <= WS_AC && WS_AC + (size_t)MROWS * DM * 2 <= WS_END, "ws map");
constexpr int CW_TMO = 0, CW_CODE = 1, CW_BAR = 4096;

constexpr int RING_OFF = 0, RING_BYTES = 131072;
constexpr int LDSCTL_OFF = RING_BYTES, MISC_OFF = LDSCTL_OFF + 320;
constexpr int LDS_BYTES = 147456;
constexpr int NWAVES = 8;

#define GAS __attribute__((address_space(1)))
#define LAS __attribute__((address_space(3)))
typedef unsigned short bf16;
typedef unsigned v4u __attribute__((ext_vector_type(4)));
typedef float f32x4 __attribute__((ext_vector_type(4)));
typedef float f32x16 __attribute__((ext_vector_type(16)));
typedef short bf16x8 __attribute__((ext_vector_type(8)));
typedef short s16x4 __attribute__((ext_vector_type(4)));
typedef GAS unsigned gu32;
#define RLX_AGENT __ATOMIC_RELAXED, __HIP_MEMORY_SCOPE_AGENT
#define LDS_WAIT() asm volatile("s_waitcnt lgkmcnt(0)" ::: "memory")
#define VM_WAIT() asm volatile("s_waitcnt vmcnt(0)" ::: "memory")
__device__ __forceinline__ unsigned f2bf(float f) { unsigned u = __builtin_bit_cast(unsigned, f); return (u + 0x7fffu + ((u >> 16) & 1u)) >> 16; }
__device__ __forceinline__ unsigned pk2(float lo, float hi) { return f2bf(lo) | (f2bf(hi) << 16); }
__device__ __forceinline__ float bf2f(unsigned short h) { return __builtin_bit_cast(float, (unsigned)h << 16); }

__device__ __forceinline__ float dpp_row_sum(float v) {
    v += __builtin_bit_cast(float, __builtin_amdgcn_update_dpp(0, __builtin_bit_cast(int, v), 0xB1, 0xF, 0xF, true));
    v += __builtin_bit_cast(float, __builtin_amdgcn_update_dpp(0, __builtin_bit_cast(int, v), 0x4E, 0xF, 0xF, true));
    v += __builtin_bit_cast(float, __builtin_amdgcn_update_dpp(0, __builtin_bit_cast(int, v), 0x141, 0xF, 0xF, true));
    v += __builtin_bit_cast(float, __builtin_amdgcn_update_dpp(0, __builtin_bit_cast(int, v), 0x140, 0xF, 0xF, true));
    return v;
}
__device__ __forceinline__ float dpp_wave_sum63(float v) {
    v = dpp_row_sum(v);
    v += __builtin_bit_cast(float, __builtin_amdgcn_update_dpp(0, __builtin_bit_cast(int, v), 0x142, 0xA, 0xF, false));
    v += __builtin_bit_cast(float, __builtin_amdgcn_update_dpp(0, __builtin_bit_cast(int, v), 0x143, 0xC, 0xF, false));
    return v;
}

namespace att {
constexpr int SLOTK = 16384, SLOTV = 16384;
constexpr int L_K = 0, L_V = 2 * SLOTK;
constexpr int L_TAB = RING_BYTES + 1024, L_WS = L_TAB + 4 * 192 * 4, L_ML = L_WS + 2048, L_END = L_ML + 2048;
static_assert(L_V + 2 * SLOTV <= RING_BYTES && L_END <= LDS_BYTES && L_TAB >= MISC_OFF + 128, "attention LDS");
__device__ __forceinline__ int crow(int r, int hi) { return (r & 3) + 8 * (r >> 2) + 4 * hi; }
typedef float f32x2_t __attribute__((ext_vector_type(2))); typedef __bf16 bf16x2_t __attribute__((ext_vector_type(2)));
__device__ __forceinline__ unsigned cvtpk_s(float lo, float hi) { f32x2_t v = {lo, hi}; bf16x2_t b = __builtin_convertvector(v, bf16x2_t); return __builtin_bit_cast(unsigned, b); }
typedef short v4i16_t __attribute__((ext_vector_type(4)));
__device__ __forceinline__ s16x4 vtr(const LAS unsigned char* p) { return __builtin_bit_cast(s16x4, __builtin_amdgcn_ds_read_tr16_b64_v4i16((LAS v4i16_t*)p)); }
__device__ __forceinline__ void glds(const bf16* g, LAS unsigned char* l) { __builtin_amdgcn_global_load_lds((const unsigned*)g, (LAS unsigned*)l, 16, 0, 0); }
__device__ __forceinline__ int t5_bucket(int delta) {
    int n = -delta, ret = 0; if (n < 0) { ret = 16; n = -n; }
    const int v = n < 8 ? n : (n < 12 ? 8 : n < 16 ? 9 : n < 23 ? 10 : n < 32 ? 11 : n < 46 ? 12 : n < 64 ? 13 : n < 91 ? 14 : 15);
    return ret + v;
}
struct AUnit { const bf16* Q; const bf16* K; const bf16* V; bf16* O; int h, NT, nkeys, qpos0, nrb; };

__device__ __forceinline__ void attn_unit(const AUnit& u, LAS unsigned char* lds, float lam, const float* __restrict__ subg) {
    const int tid = threadIdx.x, lane = tid & 63, r32 = lane & 31, hi = lane >> 5;
    const int wid = __builtin_amdgcn_readfirstlane(tid >> 6), mp = wid & 1, rb = wid >> 1;
    const bool active = rb < u.nrb;
    const int qbase = u.qpos0 + 32 * rb, chunk = qbase >> 6;
    LAS float* wsf = (LAS float*)(lds + L_WS) + wid * 64;
    const LAS float* tab = (const LAS float*)(lds + L_TAB) + u.h * 192;
    const bf16* ksrc = u.K + (size_t)lane * 512 + u.h * 128 + wid * 8;
    const bf16* vsrc = u.V + (size_t)(16 * (wid & 3) + (lane >> 2)) * 512 + u.h * 128 + (wid >> 2) * 32 + (lane & 3) * 8;
#define ATT_DMA(t, slot) do { const size_t go_ = (size_t)(t) * 64 * 512; \
        glds(ksrc + go_, lds + L_K + (slot) * SLOTK + wid * 1024); glds(ksrc + go_ + 64, lds + L_K + (slot) * SLOTK + 8192 + wid * 1024); \
        glds(vsrc + go_, lds + L_V + (slot) * SLOTV + wid * 1024); glds(vsrc + go_ + 64, lds + L_V + (slot) * SLOTV + 8192 + wid * 1024); } while (0)
    bf16x8 qr[4];
#pragma unroll
    for (int d0 = 0; d0 < 4; ++d0) qr[d0] = active ? *(const bf16x8*)(u.Q + (size_t)(32 * rb + r32) * 512 + u.h * 128 + mp * 64 + d0 * 16 + hi * 8) : (bf16x8){0, 0, 0, 0, 0, 0, 0, 0};
    float m = -1e30f, l = 0.f; f32x16 o[4];
#pragma unroll
    for (int d = 0; d < 4; ++d) o[d] = f32x16{};
    ATT_DMA(0, 0);
    for (int t = 0; t < u.NT; ++t) {
        asm volatile("s_waitcnt vmcnt(0) lgkmcnt(0)\n\ts_barrier" ::: "memory");
        if (t + 1 < u.NT) ATT_DMA(t + 1, (t + 1) & 1);
        if (active && t <= chunk) {
            const int slot = t & 1;
            const LAS unsigned char* kb = lds + L_K + slot * SLOTK + mp * 8192 + hi * 1024 + r32 * 16;
            f32x16 p0 = f32x16{}, p1 = f32x16{};
#pragma unroll
            for (int d0 = 0; d0 < 4; ++d0) { const bf16x8 b0 = *(const LAS bf16x8*)(kb + d0 * 2048), b1 = *(const LAS bf16x8*)(kb + d0 * 2048 + 512);
                p0 = __builtin_amdgcn_mfma_f32_32x32x16_bf16(b0, qr[d0], p0, 0, 0, 0); p1 = __builtin_amdgcn_mfma_f32_32x32x16_bf16(b1, qr[d0], p1, 0, 0, 0); }
            const int kq = 64 * t - qbase;
            if (kq + 63 <= -128) { const float c = tab[0];
#pragma unroll
                for (int r = 0; r < 16; ++r) { p0[r] += c; p1[r] += c; } }
            else { const int dl = kq - r32 + 128;
#pragma unroll
                for (int r = 0; r < 16; ++r) { const int j = dl + crow(r, hi); const int i0 = min(max(j, 0), 191), i1 = min(max(j + 32, 0), 191); p0[r] += tab[i0]; p1[r] += tab[i1]; } }
            if (64 * t + 64 > u.nkeys) {
#pragma unroll
                for (int r = 0; r < 16; ++r) { const int j = 64 * t + crow(r, hi); if (j >= u.nkeys) p0[r] = -1e30f; if (j + 32 >= u.nkeys) p1[r] = -1e30f; } }
            float rm = fmaxf(p0[0], p1[0]);
#pragma unroll
            for (int r = 1; r < 16; ++r) rm = fmaxf(rm, fmaxf(p0[r], p1[r]));
            { auto rr = __builtin_amdgcn_permlane32_swap(__float_as_uint(rm), __float_as_uint(rm), false, false); rm = fmaxf(__uint_as_float(rr[0]), __uint_as_float(rr[1])); }
            const float mn = fmaxf(m, rm), alpha = __builtin_amdgcn_exp2f(m - mn); m = mn;
            float rs = 0.f;
#pragma unroll
            for (int r = 0; r < 16; ++r) { p0[r] = __builtin_amdgcn_exp2f(p0[r] - mn); p1[r] = __builtin_amdgcn_exp2f(p1[r] - mn); rs += p0[r] + p1[r]; }
            l = l * alpha + rs;
            if (__builtin_amdgcn_ballot_w64(alpha != 1.0f) != 0ull) {
                if (hi == 0) wsf[r32] = alpha;
#pragma unroll
                for (int r = 0; r < 16; ++r) { const float a = wsf[crow(r, hi)];
#pragma unroll
                    for (int d = 0; d < 4; ++d) o[d][r] *= a; }
            }
            v4u pw[4];
#pragma unroll
            for (int i = 0; i < 4; ++i) { pw[0][i] = cvtpk_s(p0[2 * i], p0[2 * i + 1]); pw[1][i] = cvtpk_s(p0[8 + 2 * i], p0[9 + 2 * i]); pw[2][i] = cvtpk_s(p1[2 * i], p1[2 * i + 1]); pw[3][i] = cvtpk_s(p1[8 + 2 * i], p1[9 + 2 * i]); }
            const LAS unsigned char* vp = lds + L_V + slot * SLOTV + ((lane >> 4) & 1) * 32 + (lane & 3) * 8 + (4 * hi + ((lane & 15) >> 2)) * 64;
#pragma unroll
            for (int d = 0; d < 4; ++d)
#pragma unroll
                for (int ks = 0; ks < 4; ++ks) { const s16x4 lo = vtr(vp + d * 4096 + ks * 1024), h4 = vtr(vp + d * 4096 + ks * 1024 + 512);
                    const bf16x8 vf = (bf16x8){lo[0], lo[1], lo[2], lo[3], h4[0], h4[1], h4[2], h4[3]};
                    o[d] = __builtin_amdgcn_mfma_f32_32x32x16_bf16(__builtin_bit_cast(bf16x8, pw[ks]), vf, o[d], 0, 0, 0); }
        }
    }
#undef ATT_DMA
    __syncthreads();
    { auto rr = __builtin_amdgcn_permlane32_swap(__float_as_uint(l), __float_as_uint(l), false, false); l = __uint_as_float(rr[0]) + __uint_as_float(rr[1]); }
    if (active) {
        if (hi == 0) wsf[r32] = 1.0f / l;
#pragma unroll
        for (int r = 0; r < 16; ++r) { const float a = wsf[crow(r, hi)];
#pragma unroll
            for (int d = 0; d < 4; ++d) o[d][r] *= a; }
        if (mp == 1) { LAS float* X = (LAS float*)lds + rb * 4096;
#pragma unroll
            for (int d = 0; d < 4; ++d)
#pragma unroll
                for (int r = 0; r < 16; ++r) X[(d * 16 + r) * 64 + lane] = o[d][r]; }
    }
    __syncthreads();
    if (active && mp == 0) {
        const LAS float* X = (const LAS float*)lds + rb * 4096;
        float ss[16];
#pragma unroll
        for (int r = 0; r < 16; ++r) ss[r] = 0.f;
#pragma unroll
        for (int d = 0; d < 4; ++d)
#pragma unroll
            for (int r = 0; r < 16; ++r) { const float a = o[d][r] - lam * X[(d * 16 + r) * 64 + lane]; o[d][r] = a; ss[r] += a * a; }
#pragma unroll
        for (int off = 1; off < 32; off <<= 1)
#pragma unroll
            for (int r = 0; r < 16; ++r) ss[r] += __shfl_xor(ss[r], off);
        float g[4];
#pragma unroll
        for (int d = 0; d < 4; ++d) g[d] = subg[32 * d + r32] * (1.0f - LAM_INIT);
#pragma unroll
        for (int r = 0; r < 16; ++r) { const float rstd = 1.0f / sqrtf(ss[r] * (1.0f / 128.0f) + EPS); bf16* op = u.O + (size_t)(32 * rb + crow(r, hi)) * 1024 + u.h * 128 + r32;
#pragma unroll
            for (int d = 0; d < 4; ++d) op[32 * d] = (bf16)f2bf(o[d][r] * rstd * g[d]); }
    }
    __syncthreads();
}
}

namespace atts {
using att::crow; using att::cvtpk_s; using att::vtr; typedef unsigned u32x2_t __attribute__((ext_vector_type(2)));
constexpr int NTILE = 65, NIT = 17;
struct SUnit { const float* Kc; const float* Vc; const float* Kn; const float* Vn; const bf16* Q; bf16* O; int h; };
__device__ __forceinline__ void sattn_unit(const SUnit& u, LAS unsigned char* lds, float lam, const float* __restrict__ subg) {
    const int tid = threadIdx.x, lane = tid & 63, r32 = lane & 31, hi = lane >> 5;
    const int wid = __builtin_amdgcn_readfirstlane(tid >> 6), mp = wid & 1, kvq = wid >> 1;
    LAS float* wsf = (LAS float*)(lds + att::L_WS) + wid * 64;
    const LAS float* tab = (const LAS float*)(lds + att::L_TAB) + u.h * 192;
    LAS unsigned char* vslot = lds + kvq * 16384;
    bf16x8 qr[4];
#pragma unroll
    for (int d0 = 0; d0 < 4; ++d0) qr[d0] = *(const bf16x8*)(u.Q + (size_t)r32 * 512 + u.h * 128 + mp * 64 + d0 * 16 + hi * 8);
    const int koff = r32 * 512 + u.h * 128 + mp * 64 + 8 * hi;
    const int voff = (lane >> 4) * 512 + u.h * 128 + 64 * mp + 4 * (lane & 15);
    const int vwoff = (2 * mp + ((lane & 15) >> 3)) * 2048 + (lane >> 4) * 64 + (lane & 7) * 8;
    const int vroff = ((lane >> 4) & 1) * 32 + (lane & 3) * 8 + (4 * hi + ((lane & 15) >> 2)) * 64;
    const int nt = (kvq == 3) ? 17 : 16;
    f32x4 kf[8], vf[8]; bf16x8 kb[4];
#define ATS_ROWS(T, KP, VP) const float* KP = ((T) < 64) ? u.Kc + (size_t)(T) * 32 * 512 : u.Kn; const float* VP = ((T) < 64) ? u.Vc + (size_t)(T) * 32 * 512 : u.Vn
#define ATS_LOAD(T) do { ATS_ROWS(T, kp_, vp_); _Pragma("unroll") for (int d0 = 0; d0 < 4; ++d0) { kf[2 * d0] = *(const f32x4*)(kp_ + koff + 16 * d0); kf[2 * d0 + 1] = *(const f32x4*)(kp_ + koff + 16 * d0 + 4); } \
        _Pragma("unroll") for (int e = 0; e < 8; ++e) vf[e] = *(const f32x4*)(vp_ + voff + e * 4 * 512); } while (0)
#define ATS_CVT(slot) do { _Pragma("unroll") for (int d0 = 0; d0 < 4; ++d0) { v4u w; w.x = cvtpk_s(kf[2 * d0][0], kf[2 * d0][1]); w.y = cvtpk_s(kf[2 * d0][2], kf[2 * d0][3]); w.z = cvtpk_s(kf[2 * d0 + 1][0], kf[2 * d0 + 1][1]); w.w = cvtpk_s(kf[2 * d0 + 1][2], kf[2 * d0 + 1][3]); kb[d0] = __builtin_bit_cast(bf16x8, w); } \
        _Pragma("unroll") for (int e = 0; e < 8; ++e) { u32x2_t w; w.x = cvtpk_s(vf[e][0], vf[e][1]); w.y = cvtpk_s(vf[e][2], vf[e][3]); *(LAS u32x2_t*)(vslot + (slot) * 8192 + vwoff + e * 256) = w; } } while (0)
    float m = -1e30f, l = 0.f; f32x16 o[4];
#pragma unroll
    for (int d = 0; d < 4; ++d) o[d] = f32x16{};
    ATS_LOAD(16 * kvq); ATS_CVT(0);
    __syncthreads();
    for (int i = 0; i < NIT; ++i) {
        const bool have = i < nt, havenext = i + 1 < nt;
        if (havenext) ATS_LOAD(16 * kvq + i + 1);
        if (have) {
            const int slot = i & 1, k0 = 32 * (16 * kvq + i);
            f32x16 p = f32x16{};
#pragma unroll
            for (int d0 = 0; d0 < 4; ++d0) p = __builtin_amdgcn_mfma_f32_32x32x16_bf16(kb[d0], qr[d0], p, 0, 0, 0);
            const int kq = k0 - PAST;
            if (kq + 31 <= -128) { const float c = tab[0];
#pragma unroll
                for (int r = 0; r < 16; ++r) p[r] += c; }
            else { const int dl = kq - r32 + 128;
#pragma unroll
                for (int r = 0; r < 16; ++r) { const int j = dl + crow(r, hi); p[r] += tab[min(max(j, 0), 191)]; } }
            float rm = p[0];
#pragma unroll
            for (int r = 1; r < 16; ++r) rm = fmaxf(rm, p[r]);
            { auto rr = __builtin_amdgcn_permlane32_swap(__float_as_uint(rm), __float_as_uint(rm), false, false); rm = fmaxf(__uint_as_float(rr[0]), __uint_as_float(rr[1])); }
            const float mn = fmaxf(m, rm), alpha = __builtin_amdgcn_exp2f(m - mn); m = mn;
            float rs = 0.f;
#pragma unroll
            for (int r = 0; r < 16; ++r) { p[r] = __builtin_amdgcn_exp2f(p[r] - mn); rs += p[r]; }
            l = l * alpha + rs;
            if (__builtin_amdgcn_ballot_w64(alpha != 1.0f) != 0ull) {
                if (hi == 0) wsf[r32] = alpha;
#pragma unroll
                for (int r = 0; r < 16; ++r) { const float a = wsf[crow(r, hi)];
#pragma unroll
                    for (int d = 0; d < 4; ++d) o[d][r] *= a; }
            }
            v4u pw[2];
#pragma unroll
            for (int q = 0; q < 4; ++q) { pw[0][q] = cvtpk_s(p[2 * q], p[2 * q + 1]); pw[1][q] = cvtpk_s(p[8 + 2 * q], p[9 + 2 * q]); }
            const LAS unsigned char* vp = vslot + slot * 8192 + vroff;
#pragma unroll
            for (int d = 0; d < 4; ++d)
#pragma unroll
                for (int ks = 0; ks < 2; ++ks) { const s16x4 lo = vtr(vp + d * 2048 + ks * 1024), h4 = vtr(vp + d * 2048 + ks * 1024 + 512);
                    const bf16x8 vv = (bf16x8){lo[0], lo[1], lo[2], lo[3], h4[0], h4[1], h4[2], h4[3]};
                    o[d] = __builtin_amdgcn_mfma_f32_32x32x16_bf16(__builtin_bit_cast(bf16x8, pw[ks]), vv, o[d], 0, 0, 0); }
        }
        if (havenext) ATS_CVT((i + 1) & 1);
        __syncthreads();
    }
#undef ATS_ROWS
#undef ATS_LOAD
#undef ATS_CVT
    { auto rr = __builtin_amdgcn_permlane32_swap(__float_as_uint(l), __float_as_uint(l), false, false); l = __uint_as_float(rr[0]) + __uint_as_float(rr[1]); }
    { LAS float* X = (LAS float*)lds + wid * 4096;
#pragma unroll
        for (int d = 0; d < 4; ++d)
#pragma unroll
            for (int r = 0; r < 16; ++r) X[(d * 16 + r) * 64 + lane] = o[d][r];
        LAS float* ML = (LAS float*)(lds + att::L_ML) + wid * 64;
        if (hi == 0) { ML[2 * r32] = m; ML[2 * r32 + 1] = l; } }
    __syncthreads();
    {
        const int q = 4 * wid + (lane >> 4), g = lane & 15, d0 = 8 * g;
        const int qhi = (q >> 2) & 1, qr_ = (q & 3) + 4 * (q >> 3);
        const int eoff = ((d0 >> 5) * 16 + qr_) * 64 + (d0 & 31) + 32 * qhi;
        float a[2][8];
#pragma unroll
        for (int mm = 0; mm < 2; ++mm) {
            float mw[4], lw[4], M = -1e30f;
#pragma unroll
            for (int k = 0; k < 4; ++k) { const LAS float* ML = (const LAS float*)(lds + att::L_ML) + (2 * k + mm) * 64; mw[k] = ML[2 * q]; lw[k] = ML[2 * q + 1]; M = fmaxf(M, mw[k]); }
            float L = 0.f, sc[4];
#pragma unroll
            for (int k = 0; k < 4; ++k) { sc[k] = __builtin_amdgcn_exp2f(mw[k] - M); L += sc[k] * lw[k]; }
            const float inv = 1.0f / L;
#pragma unroll
            for (int j = 0; j < 8; ++j) { float acc = 0.f;
#pragma unroll
                for (int k = 0; k < 4; ++k) acc += sc[k] * ((const LAS float*)lds)[(2 * k + mm) * 4096 + eoff + j];
                a[mm][j] = acc * inv; }
        }
        float ss = 0.f, v[8];
#pragma unroll
        for (int j = 0; j < 8; ++j) { v[j] = a[0][j] - lam * a[1][j]; ss += v[j] * v[j]; }
        ss = dpp_row_sum(ss);
        const float rstd = 1.0f / sqrtf(ss * (1.0f / 128.0f) + EPS) * (1.0f - LAM_INIT);
        const f32x4 g0 = *(const f32x4*)(subg + d0), g1 = *(const f32x4*)(subg + d0 + 4);
        v4u w; w.x = cvtpk_s(v[0] * rstd * g0[0], v[1] * rstd * g0[1]); w.y = cvtpk_s(v[2] * rstd * g0[2], v[3] * rstd * g0[3]); w.z = cvtpk_s(v[4] * rstd * g1[0], v[5] * rstd * g1[1]); w.w = cvtpk_s(v[6] * rstd * g1[2], v[7] * rstd * g1[3]);
        *(v4u*)(u.O + (size_t)q * 1024 + u.h * 128 + d0) = w;
    }
    __syncthreads();
}
}
#define XB_TMO      128
#define XB_XCNT(j)  (256  + 64 * (j))
#define XB_XSUB(j)  (1280 + 64 * (j))
#define XB_XGEN(j)  (2304 + 64 * (j))
#define XB_TOP      3328
#define XB_TOPGEN   3392
#define XCD_BAR_WORDS 3456
#define XB_SPIN_CAP (1u << 18)

__device__ __forceinline__ unsigned xb_ld(unsigned* p)              { return __hip_atomic_load(p, __ATOMIC_RELAXED, __HIP_MEMORY_SCOPE_AGENT); }
__device__ __forceinline__ unsigned xb_add(unsigned* p, unsigned v) { return __hip_atomic_fetch_add(p, v, __ATOMIC_RELAXED, __HIP_MEMORY_SCOPE_AGENT); }
__device__ __forceinline__ unsigned xb_xcc_id() { return (unsigned)__builtin_amdgcn_s_getreg((3 << 11) | 20) & 0xFu; }
#define XB_SPIN(cond, bar) do { unsigned _sp = 0; while (cond) { __builtin_amdgcn_s_sleep(1); \
    if ((++_sp & 255u) == 0u) { if (xb_ld(&(bar)[XB_TMO])) break; if (_sp > XB_SPIN_CAP) { atomicAdd(&(bar)[XB_TMO], 1u); break; } } } } while (0)

struct XcdBarrier {
    unsigned* bar; unsigned x;
    volatile LAS unsigned* st;
};

__device__ __forceinline__ XcdBarrier xcd_barrier_post(unsigned* bar, volatile LAS unsigned* st) {
    XcdBarrier b; b.bar = bar; b.x = xb_xcc_id(); b.st = st;
    if (threadIdx.x == 0) (void)xb_add(&bar[XB_XCNT(b.x)], 1u);
    return b;
}
__device__ __forceinline__ void xcd_barrier_complete(unsigned* bar, unsigned x, unsigned& nloc, unsigned& nx) {
    const unsigned G = gridDim.x * gridDim.y * gridDim.z;
    unsigned sum, cnt, mine, sp = 0u;
    for (;;) {
        sum = 0u; cnt = 0u; mine = 0u;
#pragma unroll
        for (unsigned j = 0; j < 16; ++j) { const unsigned c = xb_ld(&bar[XB_XCNT(j)]); sum += c; cnt += (c > 0u) ? 1u : 0u; mine = (j == x) ? c : mine; }
        if (sum == G) break;
        __builtin_amdgcn_s_sleep(1);
        if ((++sp & 255u) == 0u) { if (xb_ld(&bar[XB_TMO])) break; if (sp > XB_SPIN_CAP) { atomicAdd(&bar[XB_TMO], 1u); break; } }
    }
    nloc = mine > 0u ? mine : 1u; nx = cnt > 0u ? cnt : 1u;
}

__device__ __forceinline__ void xcd_barrier(const XcdBarrier& b) {
    asm volatile("s_waitcnt vmcnt(0)" ::: "memory");
    __syncthreads();
    if (threadIdx.x == 0) {
        unsigned* bar = b.bar;
        __builtin_amdgcn_s_waitcnt(0);
        unsigned nloc = b.st[0], nx = b.st[1];
        if (nloc == 0u) { xcd_barrier_complete(bar, b.x, nloc, nx); b.st[0] = nloc; b.st[1] = nx; }
        const unsigned old = xb_add(&bar[XB_XSUB(b.x)], 1u);
        const unsigned gen = old / nloc;
        if (old + 1u == (gen + 1u) * nloc) {
            __builtin_amdgcn_fence(__ATOMIC_RELEASE, "agent");
            asm volatile("s_waitcnt vmcnt(0)" ::: "memory");
            const unsigned og = xb_add(&bar[XB_TOP], 1u);
            const unsigned tg = og / nx;
            if (og + 1u == (tg + 1u) * nx) xb_add(&bar[XB_TOPGEN], 1u);
            else XB_SPIN(xb_ld(&bar[XB_TOPGEN]) == tg, bar);
            __builtin_amdgcn_fence(__ATOMIC_ACQUIRE, "agent");
            xb_add(&bar[XB_XGEN(b.x)], 1u);
            asm volatile("s_waitcnt vmcnt(0)" ::: "memory");
        } else {
            XB_SPIN(xb_ld(&bar[XB_XGEN(b.x)]) == gen, bar);
            __builtin_amdgcn_fence(__ATOMIC_ACQUIRE, "agent");
            asm volatile("s_waitcnt vmcnt(0)" ::: "memory");
        }
    }
    __syncthreads();
}

struct Frame {
    LAS unsigned char* lds;
    volatile LAS unsigned* MISC;
    gu32* ctl;
    int tid, lane, wave;
    int vcu, G;
    const float *xp, *xs, *cache_k, *cache_v, *state_conv, *rel_bias, *ln1_g, *w_in, *lq1, *lk1, *lq2, *lk2, *subln_g, *w_dw, *b_dw, *cln_g, *cln_b, *w_out, *ln2_g, *w_up, *w_down, *lnf_g;
    float* out;
    bf16 *Win_t, *Wout_t, *Wup_t, *Wdn_t, *XN, *Q, *Kp, *Vp, *Kc, *Vc, *U, *AC, *H; float* ssq;
};
__device__ __forceinline__ float wave_sum(float v) {
#pragma unroll
    for (int o = 1; o < 64; o <<= 1) v += __shfl_xor(v, o);
    return v;
}
__device__ __forceinline__ void p0_transpose_item(const float* W, int K, int N, bf16* WT, LAS float* scr, int k0, int n0, int sn0, int lane, const float* kgain = nullptr) {
#pragma unroll 8
    for (int i = 0; i < 32; ++i) { const int kk = 2 * i + (lane >> 5); const float gk = kgain ? kgain[k0 + kk] : 1.0f; scr[kk * 33 + (lane & 31)] = W[(size_t)(k0 + kk) * N + sn0 + (lane & 31)] * gk; }
    LDS_WAIT(); asm volatile("" ::: "memory");
    const int c = lane & 7;
#pragma unroll
    for (int j = 0; j < 4; ++j) { const int n = (lane >> 3) + 8 * j; const LAS float* s = scr + (8 * c) * 33 + n;
        v4u o; o.x = pk2(s[0 * 33], s[1 * 33]); o.y = pk2(s[2 * 33], s[3 * 33]); o.z = pk2(s[4 * 33], s[5 * 33]); o.w = pk2(s[6 * 33], s[7 * 33]);
        *(GAS v4u*)(WT + (size_t)(n0 + n) * K + k0 + 8 * c) = o; }
    LDS_WAIT(); asm volatile("" ::: "memory");
}
__device__ __forceinline__ int win_src_col(int n0) {
    if (n0 < 1536) return n0;
    const int j = n0 - 1536, t = j >> 8, jj = j & 255;
    return jj < 128 ? 1536 + 128 * t + jj : 2048 + 128 * t + (jj - 128);
}
template <bool BF> __device__ __forceinline__ void rms_row(const float* xrow, const float* g, void* orow, int lane) {
    const GAS f32x4* xr = (const GAS f32x4*)xrow + lane; const GAS f32x4* gr = (const GAS f32x4*)g + lane;
    f32x4 v[4]; float s = 0.f;
#pragma unroll
    for (int j = 0; j < 4; ++j) { v[j] = xr[64 * j]; s += (v[j].x * v[j].x + v[j].y * v[j].y) + (v[j].z * v[j].z + v[j].w * v[j].w); }
    const float rstd = 1.0f / sqrtf(wave_sum(s) * (1.0f / 1024.0f) + EPS);
#pragma unroll
    for (int j = 0; j < 4; ++j) { const f32x4 gg = gr[64 * j]; const f32x4 y = v[j] * rstd * gg;
        if (BF) ((GAS unsigned long long*)orow)[lane + 64 * j] = (unsigned long long)pk2(y.x, y.y) | ((unsigned long long)pk2(y.z, y.w) << 32);
        else ((GAS f32x4*)orow)[lane + 64 * j] = y; }
}
__device__ __forceinline__ const float* x_row(const Frame& F, int R) { return R < pg8::PROMPT_ROWS ? F.xp + (size_t)R * DM : F.xs + (size_t)(R - pg8::PROMPT_ROWS) * DM; }

__device__ __forceinline__ void p0_prologue(Frame& F) {
    LAS float* scr = (LAS float*)(F.lds + RING_OFF + F.wave * 16384);
    const int gw = F.vcu * NWAVES + F.wave, NGW = F.G * NWAVES;
    constexpr int I_IN = (DM / 64) * (INCOLS / 32), I_OUT = (DM / 64) * (DM / 32), I_UP = (DM / 64) * (DFF / 32), I_DN = (DFF / 64) * (DM / 32);
    constexpr int NITEMS = I_IN + I_OUT + I_UP + I_DN;
    for (int it = gw; it < NITEMS; it += NGW) {
        int r = it;
        if (r < I_IN) { const int nb = INCOLS / 32, kb = r / nb, n0 = 32 * (r % nb); p0_transpose_item(F.w_in, DM, INCOLS, F.Win_t, scr, 64 * kb, n0, win_src_col(n0), F.lane); continue; } r -= I_IN;
        if (r < I_OUT) { const int nb = DM / 32, kb = r / nb, n0 = 32 * (r % nb); p0_transpose_item(F.w_out, DM, DM, F.Wout_t, scr, 64 * kb, n0, n0, F.lane); continue; } r -= I_OUT;
        if (r < I_UP) { const int nb = DFF / 32, kb = r / nb, n0 = 32 * (r % nb); p0_transpose_item(F.w_up, DM, DFF, F.Wup_t, scr, 64 * kb, n0, n0, F.lane, F.ln2_g); continue; } r -= I_UP;
        { const int nb = DM / 32, kb = r / nb, n0 = 32 * (r % nb); p0_transpose_item(F.w_down, DFF, DM, F.Wdn_t, scr, 64 * kb, n0, n0, F.lane); }
    }
    for (int R = gw; R < MROWS; R += NGW) rms_row<true>(x_row(F, R), F.ln1_g, F.XN + (size_t)R * DM, F.lane);
}

__device__ __forceinline__ void attn_phase(Frame& F) {
    LAS float* tab = (LAS float*)(F.lds + att::L_TAB);
    for (int i = F.tid; i < 4 * 192; i += NWAVES * 64) { const int h = i / 192, d = i % 192 - 128; tab[i] = F.rel_bias[att::t5_bucket(d) * NH + h] * LOG2E; }
    float s1 = 0.f, s2 = 0.f;
    for (int i = 0; i < 64; ++i) { s1 += F.lq1[i] * F.lk1[i]; s2 += F.lq2[i] * F.lk2[i]; }
    const float lam = expf(s1) - expf(s2) + LAM_INIT;
    __syncthreads();
    for (int pg = F.vcu; pg < 256; pg += F.G) {
        const int bh = pg >> 2, s = pg & 3, b = bh >> 2, h = bh & 3;
        for (int i = 0; i < 4; ++i) { const int qb = (i == 0) ? 15 - s : (i == 1) ? 8 + s : (i == 2) ? 7 - s : s;
            att::AUnit u; u.Q = F.Q + (size_t)(b * TP + 128 * qb) * 512; u.K = F.Kp + (size_t)b * TP * 512; u.V = F.Vp + (size_t)b * TP * 512; u.O = F.AC + (size_t)(b * TP + 128 * qb) * 1024;
            u.h = h; u.NT = 2 * qb + 2; u.nkeys = 64 * u.NT; u.qpos0 = 128 * qb; u.nrb = 4;
            att::attn_unit(u, F.lds, lam, F.subln_g); }
    }
    for (int su = F.vcu; su < NSEQ_S * NH; su += F.G) {
        const int b = su >> 2, h = su & 3;
        atts::SUnit u; u.Kc = F.cache_k + (size_t)b * PAST * 512; u.Vc = F.cache_v + (size_t)b * PAST * 512; u.Kn = F.out + O_KS + (size_t)b * TS * 512; u.Vn = F.out + O_VS + (size_t)b * TS * 512;
        u.Q = F.Q + (size_t)(pg8::PROMPT_ROWS + b * TS) * 512; u.O = F.AC + (size_t)(pg8::PROMPT_ROWS + b * TS) * 1024; u.h = h;
        atts::sattn_unit(u, F.lds, lam, F.subln_g);
    }
}

template <int NPRE, bool HP> __device__ __forceinline__ void conv_load(float (&u0)[38], float (&u1)[38], const bf16* up, const float* pp) {
#pragma unroll
    for (int i = 0; i < 38; ++i) {
        if (i >= NPRE) { const unsigned v = *(const unsigned*)(up + (size_t)i * WB); u0[i] = __builtin_bit_cast(float, v << 16); u1[i] = __builtin_bit_cast(float, v & 0xffff0000u); }
        else if (HP) { const float2 v = *(const float2*)(pp + (size_t)i * WB); u0[i] = v.x; u1[i] = v.y; }
        else { u0[i] = 0.f; u1[i] = 0.f; } }
}
__device__ __forceinline__ void conv_phase(Frame& F) {
    LAS float* red = (LAS float*)(F.lds + 96 * 1024);
    LAS float* stat = red + 128;
    const int cp = F.tid & 255, rh = F.wave >> 2, c = 2 * cp;
    float w0[CW], w1[CW];
#pragma unroll
    for (int j = 0; j < CW; ++j) { const float2 ww = *(const float2*)(F.w_dw + j * WB + c); w0[j] = ww.x; w1[j] = ww.y; }
    const float2 bdw = *(const float2*)(F.b_dw + c), lg = *(const float2*)(F.cln_g + c), lb = *(const float2*)(F.cln_b + c);
    constexpr int NU_P = NSEQ_P * (TP / 16), NU_S = NSEQ_S * (TS / 16);
    for (int un = F.vcu; un < NU_P + NU_S; un += F.G) {
        int b, t0, T, rowbase; const float* pre = nullptr; float* ost;
        if (un < NU_P) { b = un / (TP / 16); t0 = (un % (TP / 16)) * 16; T = TP; rowbase = b * TP; ost = F.out + O_CP + (size_t)b * CPAD * WB; }
        else { const int s = un - NU_P; b = s >> 1; t0 = (s & 1) * 16; T = TS; rowbase = pg8::PROMPT_ROWS + b * TS; pre = F.state_conv + (size_t)b * CPAD * WB; ost = F.out + O_CS + (size_t)b * CPAD * WB; }
        const int tb = t0 + 8 * rh;
        float u0[38], u1[38];
        { const int npre = tb >= CPAD ? 0 : CPAD - tb;
            const bf16* up = F.U + (size_t)(rowbase + tb - CPAD) * WB + c; const float* pp = pre ? pre + (size_t)tb * WB + c : nullptr;
            if (npre == 0) conv_load<0, false>(u0, u1, up, pp);
            else if (pre) { if (npre == 30) conv_load<30, true>(u0, u1, up, pp); else if (npre == 22) conv_load<22, true>(u0, u1, up, pp); else if (npre == 14) conv_load<14, true>(u0, u1, up, pp); else conv_load<6, true>(u0, u1, up, pp); }
            else { if (npre == 30) conv_load<30, false>(u0, u1, up, pp); else if (npre == 22) conv_load<22, false>(u0, u1, up, pp); else if (npre == 14) conv_load<14, false>(u0, u1, up, pp); else conv_load<6, false>(u0, u1, up, pp); } }
        float y0[8], y1[8];
#pragma unroll
        for (int i = 0; i < 8; ++i) { float a0 = bdw.x, a1 = bdw.y;
#pragma unroll
            for (int j = 0; j < CW; ++j) { a0 += w0[j] * u0[i + j]; a1 += w1[j] * u1[i + j]; }
            y0[i] = a0; y1[i] = a1; }
#pragma unroll
        for (int i = 0; i < 8; ++i) { const float s1 = dpp_wave_sum63(y0[i] + y1[i]), s2 = dpp_wave_sum63(y0[i] * y0[i] + y1[i] * y1[i]);
            if (F.lane == 63) { red[F.wave * 16 + 2 * i] = s1; red[F.wave * 16 + 2 * i + 1] = s2; } }
        __syncthreads();
        if (F.tid < 16) { const int r = F.tid, h = r >> 3, i = r & 7; float a = 0.f, q = 0.f;
#pragma unroll
            for (int ww = 0; ww < 4; ++ww) { a += red[(4 * h + ww) * 16 + 2 * i]; q += red[(4 * h + ww) * 16 + 2 * i + 1]; }
            const float mean = a * (1.0f / WB), var = fmaxf(q * (1.0f / WB) - mean * mean, 0.f);
            stat[2 * r] = mean; stat[2 * r + 1] = 1.0f / sqrtf(var + EPS); }
        __syncthreads();
#pragma unroll
        for (int i = 0; i < 8; ++i) { const float mean = stat[2 * (8 * rh + i)], rstd = stat[2 * (8 * rh + i) + 1];
            float v0 = (y0[i] - mean) * rstd * lg.x + lb.x, v1 = (y1[i] - mean) * rstd * lg.y + lb.y; v0 = v0 * pg8::sigmoidf_fast(v0); v1 = v1 * pg8::sigmoidf_fast(v1);
            *(unsigned*)(F.AC + (size_t)(rowbase + tb + i) * 1024 + 512 + c) = pk2(v0, v1);
            const int t = tb + i; if (t >= T - CPAD) *(float2*)(ost + (size_t)(t - (T - CPAD)) * WB + c) = make_float2(u0[CPAD + i], u1[CPAD + i]); }
        __syncthreads();
    }
}

#ifndef MK_N_LAUNCHES
#define MK_N_LAUNCHES 1
#endif
constexpr int N_PHASES = 8;
constexpr int N_LAUNCHES = MK_N_LAUNCHES;
struct Args { const float* in[22]; float* out; unsigned char* ws; int ph_lo, ph_hi, li, pad; };
__global__ void __launch_bounds__(NWAVES * 64, 2) fwd_kernel(Args args) {
    extern __shared__ __attribute__((aligned(16))) unsigned char lds[];
    Frame F;
    F.lds = (LAS unsigned char*)lds;
    F.MISC = (volatile LAS unsigned*)(F.lds + MISC_OFF);
    F.tid = threadIdx.x; F.lane = F.tid & 63; F.wave = __builtin_amdgcn_readfirstlane(F.tid >> 6);
    F.G = gridDim.x; { const int bx = blockIdx.x; F.vcu = (F.G % 8 == 0) ? (bx % 8) * (F.G / 8) + bx / 8 : bx; }
    unsigned char* ws = args.ws;
    F.ctl = (gu32*)(ws + WS_CTL);
    F.xp = args.in[0]; F.xs = args.in[1]; F.cache_k = args.in[2]; F.cache_v = args.in[3]; F.state_conv = args.in[4]; F.rel_bias = args.in[5]; F.ln1_g = args.in[6]; F.w_in = args.in[7];
    F.lq1 = args.in[8]; F.lk1 = args.in[9]; F.lq2 = args.in[10]; F.lk2 = args.in[11]; F.subln_g = args.in[12]; F.w_dw = args.in[13]; F.b_dw = args.in[14]; F.cln_g = args.in[15]; F.cln_b = args.in[16];
    F.w_out = args.in[17]; F.ln2_g = args.in[18]; F.w_up = args.in[19]; F.w_down = args.in[20]; F.lnf_g = args.in[21]; F.out = args.out;
    F.Win_t = (bf16*)(ws + WS_WIN); F.Wout_t = (bf16*)(ws + WS_WOUT); F.Wup_t = (bf16*)(ws + WS_WUP); F.Wdn_t = (bf16*)(ws + WS_WDN); F.XN = (bf16*)(ws + WS_XN);
    F.Q = (bf16*)(ws + WS_Q); F.Kp = (bf16*)(ws + WS_KP); F.Vp = (bf16*)(ws + WS_VP); F.Kc = (bf16*)(ws + WS_KC); F.Vc = (bf16*)(ws + WS_VC); F.U = (bf16*)(ws + WS_U); F.AC = (bf16*)(ws + WS_AC); F.H = (bf16*)(ws + WS_H); F.ssq = (float*)(ws + WS_SSQ);
    for (int u = F.tid; u < (LDS_BYTES - LDSCTL_OFF) / 4; u += NWAVES * 64) ((LAS unsigned*)(F.lds + LDSCTL_OFF))[u] = 0u;
    __syncthreads();
    XcdBarrier bar; bar.bar = (unsigned*)(F.ctl + CW_BAR); bar.x = 0; bar.st = nullptr;
    if (N_LAUNCHES == 1) bar = xcd_barrier_post((unsigned*)(F.ctl + CW_BAR), F.MISC + 8);
    const int lo = args.ph_lo, hi = args.ph_hi;
#define IN(k) (lo <= (k) && (k) < hi)
#define SEAM(k) do { if (IN(k) && IN((k) + 1)) xcd_barrier(bar); } while (0)
#ifndef REP_PHASE
#define REP_PHASE -1
#endif
#ifndef REP_N
#define REP_N 1
#endif
#define NREP(k) (((k) == REP_PHASE) ? 1 + REP_N : 1)
    const float QSCALE = 0.125f * LOG2E;

    if (IN(0)) for (int rep = 0; rep < NREP(0); ++rep) { p0_prologue(F); SEAM(0); }
    if (IN(1)) for (int rep = 0; rep < NREP(1); ++rep) {
        pg8::Gemm g{F.XN, F.Win_t, MROWS, INCOLS, DM}; pg8::StaticOrder S; S.init(MROWS, INCOLS, F.G, (int)blockIdx.x);
        pg8::EpiProj E{F.Q, F.Kp, F.Vp, F.Kc, F.Vc, F.U, F.out + O_KP, F.out + O_VP, F.out + O_KS, F.out + O_VS, QSCALE};
        pg8::gemm_phase<pg8::EpiProj, pg8::StaticOrder, true, true>(F.lds + RING_OFF, g, S, E);
        SEAM(1);
    }
    if (IN(2)) { for (int rep = 0; rep < NREP(2); ++rep) attn_phase(F); for (int rep = 0; rep < NREP(8); ++rep) conv_phase(F); SEAM(2); }
    if (IN(3)) for (int rep = 0; rep < NREP(3); ++rep) {
        pg8::Gemm g{F.AC, F.Wout_t, MROWS, DM, DM}; pg8::StaticOrder S; S.init(MROWS, DM, F.G, (int)blockIdx.x);
        pg8::EpiRes1 E{F.xp, F.xs, F.XN, F.ssq};
        pg8::gemm_phase<pg8::EpiRes1, pg8::StaticOrder, true, true>(F.lds + RING_OFF, g, S, E);
        SEAM(3);
    }
    if (IN(5)) for (int rep = 0; rep < NREP(5); ++rep) {
        pg8::Gemm g{F.XN, F.Wup_t, MROWS, DFF, DM}; pg8::StaticOrder S; S.init(MROWS, DFF, F.G, (int)blockIdx.x);
        pg8::EpiRelu2 E{F.H, DFF, F.ssq, EPS};
        pg8::gemm_phase<pg8::EpiRelu2, pg8::StaticOrder, true, true>(F.lds + RING_OFF, g, S, E);
        SEAM(5);
    }
    if (IN(6)) {
        pg8::Gemm g{F.H, F.Wdn_t, MROWS, DM, DFF}; pg8::StaticOrder S; S.init(MROWS, DM, F.G, (int)blockIdx.x);
        pg8::EpiRes2 E{F.XN, F.out};
        pg8::gemm_phase<pg8::EpiRes2, pg8::StaticOrder, true, true>(F.lds + RING_OFF, g, S, E);
        SEAM(6);
    }
    if (IN(7)) {
        const int gw = F.vcu * NWAVES + F.wave, NGW = F.G * NWAVES;
        for (int R = gw; R < MROWS; R += NGW) rms_row<false>(F.out + (size_t)R * DM, F.lnf_g, F.out + (size_t)R * DM, F.lane);
    }
#undef IN
#undef SEAM
}

extern "C" void kernel_launch(void* const* d_in, const int* in_sizes, int n_in, void* d_out, int out_size, void* d_ws, size_t ws_size, hipStream_t stream) {
    static int grid = 0;
    if (grid == 0) {
        if (n_in != 22 || (size_t)out_size != O_END || ws_size < WS_END) { fprintf(stderr, "kernel_launch: unexpected shapes: n_in %d out %d ws %zu; nothing launched\n", n_in, out_size, ws_size); grid = -1; return; }
        int dev = 0, cus = 0, per_cu = 0;
        if (hipGetDevice(&dev) != hipSuccess || hipDeviceGetAttribute(&cus, hipDeviceAttributeMultiprocessorCount, dev) != hipSuccess) { fprintf(stderr, "kernel_launch: device query failed\n"); grid = -1; return; }
        if (hipFuncSetAttribute((const void*)fwd_kernel, hipFuncAttributeMaxDynamicSharedMemorySize, LDS_BYTES) != hipSuccess) { fprintf(stderr, "kernel_launch: hipFuncSetAttribute failed\n"); grid = -1; return; }
        if (hipOccupancyMaxActiveBlocksPerMultiprocessor(&per_cu, (const void*)fwd_kernel, NWAVES * 64, LDS_BYTES) != hipSuccess || per_cu < 1) { fprintf(stderr, "kernel_launch: occupancy query reports %d blocks per CU\n", per_cu); }
        (void)hipGetLastError();
        grid = cus;
    }
    if (grid < 0) return;
    (void)hipMemsetAsync((char*)d_ws + WS_CTL, 0, CTL_ZERO_BYTES, stream);
    Args a{};
    for (int i = 0; i < 22; ++i) a.in[i] = (const float*)d_in[i];
    a.out = (float*)d_out; a.ws = (unsigned char*)d_ws;
    for (int li = 0; li < N_LAUNCHES; ++li) {
        a.ph_lo = (N_LAUNCHES == 1) ? 0 : li; a.ph_hi = (N_LAUNCHES == 1) ? N_PHASES : li + 1; a.li = li;
        hipLaunchKernelGGL(fwd_kernel, dim3(grid), dim3(NWAVES * 64), LDS_BYTES, stream, a);
    }
}
```

```cpp
#include <hip/hip_runtime.h>
#include <hip/hip_bf16.h>
#include <cstdio>
#include <cstdint>
#include <cmath>
namespace pg8 {
#define PG8_LAS __attribute__((address_space(3)))
typedef unsigned short bf16_t;
typedef short bf16x8 __attribute__((ext_vector_type(8)));
typedef float f32x4 __attribute__((ext_vector_type(4)));
typedef unsigned u32x4 __attribute__((ext_vector_type(4)));
constexpr int BM = 256, BK = 64, HALF = 128, HTB = HALF * BK * 2  , STAGE_BYTES = 8 * HTB, NXCD = 8, WGM = 8;

__host__ __device__ __forceinline__ int lds_byte(int r, int c) { const int st = (r >> 4) * 2 + (c >> 5), rr = r & 15, cc = c & 31, ob = rr * 64 + cc * 2; return st * 1024 + (ob ^ (((ob >> 9) & 1) << 5)); }
__host__ __device__ __forceinline__ void stage_rc(int b, int& R, int& C) { const int st = b / 1024, sb = b % 1024, swz = sb ^ (((sb >> 9) & 1) << 5); R = (st >> 1) * 16 + swz / 64; C = (st & 1) * 32 + (swz % 64) / 2; }
__host__ __device__ __forceinline__ int perm32(int rho) { const int n = rho >> 4, i = rho & 15; return 8 * (i >> 2) + 4 * n + (i & 3); }

struct Unit { int pm, pn, kz; };
struct Gemm { const bf16_t* A; const bf16_t* Bt; int M, N, K; int ld; };

struct StaticOrder {
    int nM, nN, nwg, G, c;
    __host__ __device__ void init(int M, int N, int G_, int c_) { nM = M / BM; nN = N / BM; nwg = nM * nN; G = G_; c = c_; }
    __host__ __device__ bool next(int i, Unit& u) const {
        const long L = (long)i * G + c; if (L >= nwg) return false;
        int wgid = (int)L; { const int q = nwg / NXCD, r = nwg % NXCD, xcd = wgid % NXCD, off = wgid / NXCD; wgid = (xcd < r ? xcd * (q + 1) : r * (q + 1) + (xcd - r) * q) + off; }
        const int nig = WGM * nN, gid = wgid / nig, fm = gid * WGM, gsz = (nM - fm) < WGM ? (nM - fm) : WGM;
        u.pm = fm + ((wgid % nig) % gsz); u.pn = (wgid % nig) / gsz; u.kz = 0; return true;
    }
    __device__ __forceinline__ void a_ready(const Unit&) const {}
    __device__ __forceinline__ void done(const Unit&) const {}
};


struct ListOrder {
    int n, S, c, nN, nKz;
    __device__ bool next(int i, Unit& u) const { const int j = c + i * S; if (j >= n) return false; u.kz = j % nKz; const int t = j / nKz; u.pn = t % nN; u.pm = t / nN; return true; }
    __device__ __forceinline__ void a_ready(const Unit&) const {}
    __device__ __forceinline__ void done(const Unit&) const {}
};

__device__ __forceinline__ unsigned cvt_pk_bf16(float lo, float hi) { unsigned r; asm volatile("v_cvt_pk_bf16_f32 %0, %1, %2" : "=v"(r) : "v"(lo), "v"(hi)); return r; }
__device__ __forceinline__ u32x4 pack8(const f32x4 v0, const f32x4 v1) { u32x4 w; w.x = cvt_pk_bf16(v0[0], v0[1]); w.y = cvt_pk_bf16(v0[2], v0[3]); w.z = cvt_pk_bf16(v1[0], v1[1]); w.w = cvt_pk_bf16(v1[2], v1[3]); return w; }
__device__ __forceinline__ float sigmoidf_fast(float g) { return __builtin_amdgcn_rcpf(1.0f + __builtin_amdgcn_exp2f(-1.4426950408889634f * g)); }

constexpr int PROMPT_ROWS = 32768;
constexpr int KC_ROWS = 2112;

struct EpiProj {
    static constexpr bool PERM = true, AFTER_DRAIN = false;
    bf16_t *Q, *Kb, *Vb, *U; float *ok, *ov; float qscale; bool sample;
    __device__ __forceinline__ void operator()(const f32x4 (&acc)[2][2][4][2], const Unit& u, int wr, int wc, int fr, int fq) const {
        const int pn = u.pn;
        const int row0 = u.pm * BM + wr * 64 + fr, cl = wc * 32 + 8 * fq;
        if (pn < 2) {
#pragma unroll
            for (int ai = 0; ai < 2; ++ai)
#pragma unroll
                for (int m = 0; m < 4; ++m) { bf16_t* rp = Q + (size_t)(row0 + ai * HALF + m * 16) * 512 + pn * 256 + cl;
#pragma unroll
                    for (int bj = 0; bj < 2; ++bj) *(u32x4*)(rp + bj * HALF) = pack8(acc[ai][bj][m][0] * qscale, acc[ai][bj][m][1] * qscale); }
        } else if (pn < 6) {
            const bool isV = pn >= 4; const int c0 = (pn & 1) * 256 + cl;
#pragma unroll
            for (int ai = 0; ai < 2; ++ai)
#pragma unroll
                for (int m = 0; m < 4; ++m) { const int R = row0 + ai * HALF + m * 16;
                    if (!sample) { bf16_t* bp = (isV ? Vb : Kb) + (size_t)R * 512 + c0; float* fp = (isV ? ov : ok) + (size_t)R * 512 + c0;
#pragma unroll
                        for (int bj = 0; bj < 2; ++bj) { const f32x4 v0 = acc[ai][bj][m][0], v1 = acc[ai][bj][m][1];
                            *(u32x4*)(bp + bj * HALF) = pack8(v0, v1); *(f32x4*)(fp + bj * HALF) = v0; *(f32x4*)(fp + bj * HALF + 4) = v1; } }
                    else { float* fp = (isV ? ov : ok) + (size_t)R * 512 + c0;
#pragma unroll
                        for (int bj = 0; bj < 2; ++bj) { *(f32x4*)(fp + bj * HALF) = acc[ai][bj][m][0]; *(f32x4*)(fp + bj * HALF + 4) = acc[ai][bj][m][1]; } } }
        } else {
            const int c0 = (pn - 6) * 128 + cl;
#pragma unroll
            for (int ai = 0; ai < 2; ++ai)
#pragma unroll
                for (int m = 0; m < 4; ++m) { const int R = row0 + ai * HALF + m * 16; f32x4 o0, o1;
#pragma unroll
                    for (int i = 0; i < 4; ++i) { o0[i] = acc[ai][0][m][0][i] * sigmoidf_fast(acc[ai][1][m][0][i]); o1[i] = acc[ai][0][m][1][i] * sigmoidf_fast(acc[ai][1][m][1][i]); }
                    *(u32x4*)(U + (size_t)R * 512 + c0) = pack8(o0, o1); }
        }
    }
};
struct EpiRes1 {
    static constexpr bool PERM = true, AFTER_DRAIN = false;
    const float* res; bf16_t* XB; float* ssq;
    __device__ __forceinline__ void operator()(const f32x4 (&acc)[2][2][4][2], const Unit& u, int wr, int wc, int fr, int fq) const {
        const int row0 = u.pm * BM + wr * 64 + fr, col0 = u.pn * BM + wc * 32 + 8 * fq;
        const float* rbase = res;
#pragma unroll
        for (int ai = 0; ai < 2; ++ai)
#pragma unroll
            for (int m = 0; m < 4; ++m) { const int R = row0 + ai * HALF + m * 16; const size_t off = (size_t)R * 1024 + col0; float q = 0.f;
#pragma unroll
                for (int bj = 0; bj < 2; ++bj) { const f32x4 r0 = *(const f32x4*)(rbase + off + bj * HALF), r1 = *(const f32x4*)(rbase + off + bj * HALF + 4);
                    const f32x4 v0 = r0 + acc[ai][bj][m][0], v1 = r1 + acc[ai][bj][m][1];
                    q += (v0[0] * v0[0] + v0[1] * v0[1]) + (v0[2] * v0[2] + v0[3] * v0[3]) + (v1[0] * v1[0] + v1[1] * v1[1]) + (v1[2] * v1[2] + v1[3] * v1[3]);
                    *(u32x4*)(XB + off + bj * HALF) = pack8(v0, v1); }
                q += __shfl_xor(q, 16); q += __shfl_xor(q, 32);
                if (fq == 0) ssq[(size_t)R * 16 + u.pn * 4 + wc] = q; }
    }
};
struct EpiRelu2 {
    static constexpr bool PERM = true, AFTER_DRAIN = false;
    bf16_t* O; int ldc; const float* ssq; float eps;
    __device__ __forceinline__ void operator()(const f32x4 (&acc)[2][2][4][2], const Unit& u, int wr, int wc, int fr, int fq) const {
        const int row0 = u.pm * BM + wr * 64 + fr, col0 = u.pn * BM + wc * 32 + 8 * fq;
#pragma unroll
        for (int ai = 0; ai < 2; ++ai)
#pragma unroll
            for (int m = 0; m < 4; ++m) { const int R = row0 + ai * HALF + m * 16; const f32x4* sp = (const f32x4*)(ssq + (size_t)R * 16);
                const f32x4 s0 = sp[0], s1 = sp[1], s2 = sp[2], s3 = sp[3]; const f32x4 st = (s0 + s1) + (s2 + s3);
                const float rstd = 1.0f / sqrtf(((st[0] + st[1]) + (st[2] + st[3])) * (1.0f / 1024.0f) + eps);
                bf16_t* rp = O + (size_t)R * ldc + col0;
#pragma unroll
                for (int bj = 0; bj < 2; ++bj) { f32x4 v0 = acc[ai][bj][m][0], v1 = acc[ai][bj][m][1];
#pragma unroll
                    for (int i = 0; i < 4; ++i) { const float a = fmaxf(v0[i], 0.f) * rstd, b = fmaxf(v1[i], 0.f) * rstd; v0[i] = a * a; v1[i] = b * b; }
                    *(u32x4*)(rp + bj * HALF) = pack8(v0, v1); } }
    }
};
struct EpiRes2 {
    static constexpr bool PERM = true, AFTER_DRAIN = false;
    const bf16_t* XB; float* out;
    __device__ __forceinline__ void operator()(const f32x4 (&acc)[2][2][4][2], const Unit& u, int wr, int wc, int fr, int fq) const {
        const int row0 = u.pm * BM + wr * 64 + fr, col0 = u.pn * BM + wc * 32 + 8 * fq;
#pragma unroll
        for (int ai = 0; ai < 2; ++ai)
#pragma unroll
            for (int m = 0; m < 4; ++m) { const size_t off = (size_t)(row0 + ai * HALF + m * 16) * 1024 + col0;
#pragma unroll
                for (int bj = 0; bj < 2; ++bj) { const u32x4 w = *(const u32x4*)(XB + off + bj * HALF); f32x4 r0, r1;
                    r0[0] = __builtin_bit_cast(float, w.x << 16); r0[1] = __builtin_bit_cast(float, w.x & 0xffff0000u); r0[2] = __builtin_bit_cast(float, w.y << 16); r0[3] = __builtin_bit_cast(float, w.y & 0xffff0000u);
                    r1[0] = __builtin_bit_cast(float, w.z << 16); r1[1] = __builtin_bit_cast(float, w.z & 0xffff0000u); r1[2] = __builtin_bit_cast(float, w.w << 16); r1[3] = __builtin_bit_cast(float, w.w & 0xffff0000u);
                    *(f32x4*)(out + off + bj * HALF) = r0 + acc[ai][bj][m][0]; *(f32x4*)(out + off + bj * HALF + 4) = r1 + acc[ai][bj][m][1]; } }
    }
};

struct EpiPartial {
    static constexpr bool PERM = false, AFTER_DRAIN = false;
    float* slab; size_t slab_stride;
    __device__ __forceinline__ void operator()(const f32x4 (&acc)[2][2][4][2], const Unit& u, int wr, int wc, int fr, int fq) const {
        const int row0 = u.pm * BM + wr * 64 + fr, col0 = u.pn * BM + wc * 32 + 4 * fq; float* base = slab + (size_t)u.kz * slab_stride;
#pragma unroll
        for (int ai = 0; ai < 2; ++ai)
#pragma unroll
            for (int m = 0; m < 4; ++m) { float* rp = base + (size_t)(row0 + ai * HALF + m * 16) * 1024 + col0;
#pragma unroll
                for (int bj = 0; bj < 2; ++bj)
#pragma unroll
                    for (int n = 0; n < 2; ++n) *(f32x4*)(rp + bj * HALF + n * 16) = acc[ai][bj][m][n]; }
    }
};

template <class Epi, class Sched, bool ALIGN_EPI = false, bool SP2 = false>
__device__ __forceinline__ void gemm_phase(PG8_LAS unsigned char* lds, const Gemm g, const Sched& S, const Epi& E) {
    const int tid = threadIdx.x, wid = __builtin_amdgcn_readfirstlane(tid >> 6), lane = tid & 63, wr = wid >> 2, wc = wid & 3, fr = lane & 15, fq = lane >> 4;
    const int K = g.K, nt = K / BK, LD = g.ld ? g.ld : g.K;
    unsigned voffA[2], voffB[2];
#pragma unroll
    for (int i = 0; i < 2; ++i) { int R, C; stage_rc(tid * 16 + i * 8192, R, C); const int Rb = Epi::PERM ? ((R & ~31) + perm32(R & 31)) : R;
        voffA[i] = (unsigned)(R * LD + C) * 2u; voffB[i] = (unsigned)(Rb * LD + C) * 2u; }
    const size_t kstep = (size_t)(BK * 2);
    const size_t hstep = (size_t)HALF * LD * 2;
    const size_t tstep = 2 * hstep;
    const unsigned ldsw = (unsigned)wid * 1024u;
    const int aoff = lds_byte(wr * 64 + fr, fq * 8), boff = lds_byte(wc * 32 + fr, fq * 8);
#define PG8_SA(b, h) (((b) * 2 + (h)) * HTB)
#define PG8_SB(b, h) ((4 + (b) * 2 + (h)) * HTB)
#define PG8_STAGE(bufoff, gbase, voff) do { _Pragma("unroll") for (int _i = 0; _i < 2; ++_i) \
        __builtin_amdgcn_global_load_lds((const unsigned*)((const char*)(gbase) + (voff)[_i]), (PG8_LAS unsigned*)(lds + (bufoff) + ldsw + _i * 8192), 16, 0, 0); } while (0)
#define PG8_LDA(dst, b, h) do { _Pragma("unroll") for (int m = 0; m < 4; ++m) _Pragma("unroll") for (int k = 0; k < 2; ++k) dst[m][k] = *(const PG8_LAS bf16x8*)(lds + PG8_SA(b, h) + aoff + m * 2048 + k * 1024); } while (0)
#define PG8_LDB(dst, b, h) do { _Pragma("unroll") for (int n = 0; n < 2; ++n) _Pragma("unroll") for (int k = 0; k < 2; ++k) dst[n][k] = *(const PG8_LAS bf16x8*)(lds + PG8_SB(b, h) + boff + n * 2048 + k * 1024); } while (0)
#define PG8_MMA(ai, bj, At, Bt) do { __builtin_amdgcn_s_setprio(1); _Pragma("unroll") for (int m = 0; m < 4; ++m) _Pragma("unroll") for (int n = 0; n < 2; ++n) _Pragma("unroll") for (int k = 0; k < 2; ++k) \
        acc[ai][bj][m][n] = __builtin_amdgcn_mfma_f32_16x16x32_bf16(Bt[n][k], At[m][k], acc[ai][bj][m][n], 0, 0, 0); __builtin_amdgcn_s_setprio(0); } while (0)
#define PG8_WAIT_V(n) asm volatile("s_waitcnt vmcnt(" #n ")" ::: "memory")
#define PG8_WAIT_L(n) asm volatile("s_waitcnt lgkmcnt(" #n ")" ::: "memory")
#define PG8_BAR __builtin_amdgcn_s_barrier()
#define PG8_SCHED __builtin_amdgcn_sched_barrier(0)
    Unit cur, nxt; int ui = 0;
    if (!S.next(0, cur)) return;
    f32x4 acc[2][2][4][2];
#pragma unroll
    for (int a = 0; a < 2; ++a)
#pragma unroll
        for (int b = 0; b < 2; ++b)
#pragma unroll
            for (int m = 0; m < 4; ++m)
#pragma unroll
                for (int n = 0; n < 2; ++n) acc[a][b][m][n] = (f32x4){0.f, 0.f, 0.f, 0.f};
    bf16x8 At[4][2], B0[2][2], B1[2][2];
    const char* cA = (const char*)g.A + (size_t)cur.pm * tstep + (size_t)cur.kz * K * 2; const char* cB = (const char*)g.Bt + (size_t)cur.pn * tstep + (size_t)cur.kz * K * 2;
    S.a_ready(cur);
    if constexpr (SP2) {
        PG8_STAGE(PG8_SB(0, 0), cB, voffB); PG8_STAGE(PG8_SB(0, 1), cB + hstep, voffB); PG8_STAGE(PG8_SA(0, 0), cA, voffA); PG8_STAGE(PG8_SA(0, 1), cA + hstep, voffA);
        if (wr == 1) PG8_BAR;
        PG8_WAIT_V(2); PG8_BAR;
        PG8_STAGE(PG8_SB(1, 0), cB + kstep, voffB); PG8_STAGE(PG8_SA(1, 0), cA + kstep, voffA); PG8_STAGE(PG8_SB(1, 1), cB + hstep + kstep, voffB);
        PG8_WAIT_V(6); PG8_BAR;
    } else {
        PG8_STAGE(PG8_SB(0, 0), cB, voffB); PG8_STAGE(PG8_SA(0, 0), cA, voffA); PG8_STAGE(PG8_SB(0, 1), cB + hstep, voffB); PG8_STAGE(PG8_SA(0, 1), cA + hstep, voffA);
        if (wr == 1) PG8_BAR;
        PG8_WAIT_V(4); PG8_BAR;
        PG8_STAGE(PG8_SB(1, 0), cB + kstep, voffB); PG8_STAGE(PG8_SA(1, 0), cA + kstep, voffA); PG8_STAGE(PG8_SB(1, 1), cB + hstep + kstep, voffB);
        PG8_WAIT_V(6); PG8_BAR;
    }
    for (;;) {
        const bool has_next = S.next(ui + 1, nxt);
        const char* nA = has_next ? (const char*)g.A + (size_t)nxt.pm * tstep + (size_t)nxt.kz * K * 2 : cA; const char* nB = has_next ? (const char*)g.Bt + (size_t)nxt.pn * tstep + (size_t)nxt.kz * K * 2 : cB;
        for (int t = 0; t < nt; t += 2) {
            const bool last = (t == nt - 2);
            const char* a1 = cA + (size_t)(t + 1) * kstep;
            const char* a2 = last ? nA : cA + (size_t)(t + 2) * kstep; const char* b2 = last ? nB : cB + (size_t)(t + 2) * kstep;
            const char* a3 = a2 + kstep; const char* b3 = b2 + kstep;
            if (last && has_next) S.a_ready(nxt);
            if constexpr (SP2) {
            PG8_LDB(B0, 0, 0); PG8_LDB(B1, 0, 1); PG8_SCHED; PG8_LDA(At, 0, 0); PG8_STAGE(PG8_SA(1, 1), a1 + hstep, voffA);
            PG8_WAIT_V(8); PG8_WAIT_L(0); PG8_BAR; PG8_MMA(0, 0, At, B0); PG8_MMA(0, 1, At, B1); PG8_BAR; PG8_SCHED;
            PG8_LDA(At, 0, 1); PG8_STAGE(PG8_SB(0, 0), b2, voffB); PG8_STAGE(PG8_SB(0, 1), b2 + hstep, voffB); PG8_STAGE(PG8_SA(0, 0), a2, voffA);
            PG8_WAIT_V(8); PG8_WAIT_L(0); PG8_BAR; PG8_MMA(1, 0, At, B0); PG8_MMA(1, 1, At, B1); PG8_BAR; PG8_SCHED;
            PG8_LDB(B0, 1, 0); PG8_LDB(B1, 1, 1); PG8_SCHED; PG8_LDA(At, 1, 0); PG8_STAGE(PG8_SA(0, 1), a2 + hstep, voffA);
            PG8_WAIT_V(8); PG8_WAIT_L(0); PG8_BAR; PG8_MMA(0, 0, At, B0); PG8_MMA(0, 1, At, B1); PG8_BAR; PG8_SCHED;
            PG8_LDA(At, 1, 1); PG8_STAGE(PG8_SB(1, 0), b3, voffB); PG8_STAGE(PG8_SB(1, 1), b3 + hstep, voffB); PG8_STAGE(PG8_SA(1, 0), a3, voffA);
            PG8_WAIT_V(8); PG8_WAIT_L(0); PG8_BAR; PG8_MMA(1, 0, At, B0); PG8_MMA(1, 1, At, B1); PG8_BAR; PG8_SCHED;
            } else {
            PG8_LDB(B0, 0, 0); PG8_SCHED; PG8_LDA(At, 0, 0); PG8_STAGE(PG8_SA(1, 1), a1 + hstep, voffA);
            PG8_WAIT_L(8); PG8_BAR; PG8_WAIT_L(0); PG8_MMA(0, 0, At, B0); PG8_BAR; PG8_SCHED;
            PG8_LDB(B1, 0, 1); PG8_STAGE(PG8_SB(0, 0), b2, voffB);
            PG8_BAR; PG8_WAIT_L(0); PG8_MMA(0, 1, At, B1); PG8_BAR;
            PG8_LDA(At, 0, 1); PG8_STAGE(PG8_SA(0, 0), a2, voffA);
            PG8_BAR; PG8_WAIT_L(0); PG8_MMA(1, 0, At, B0); PG8_BAR; PG8_SCHED;
            PG8_STAGE(PG8_SB(0, 1), b2 + hstep, voffB);
            PG8_WAIT_V(6); PG8_BAR; PG8_MMA(1, 1, At, B1); PG8_BAR;
            PG8_LDB(B0, 1, 0); PG8_SCHED; PG8_LDA(At, 1, 0); PG8_STAGE(PG8_SA(0, 1), a2 + hstep, voffA);
            PG8_WAIT_L(8); PG8_BAR; PG8_WAIT_L(0); PG8_MMA(0, 0, At, B0); PG8_BAR; PG8_SCHED;
            PG8_LDB(B1, 1, 1); PG8_STAGE(PG8_SB(1, 0), b3, voffB);
            PG8_BAR; PG8_WAIT_L(0); PG8_MMA(0, 1, At, B1); PG8_BAR;
            PG8_LDA(At, 1, 1); PG8_STAGE(PG8_SA(1, 0), a3, voffA);
            PG8_BAR; PG8_WAIT_L(0); PG8_MMA(1, 0, At, B0); PG8_BAR; PG8_SCHED;
            PG8_STAGE(PG8_SB(1, 1), b3 + hstep, voffB);
            PG8_WAIT_V(6); PG8_BAR; PG8_MMA(1, 1, At, B1); PG8_BAR;
            }
        }
        if constexpr (ALIGN_EPI) { if (wr == 0) PG8_BAR; }
        if constexpr (!Epi::AFTER_DRAIN) { E(acc, cur, wr, wc, fr, fq); S.done(cur); }
        if (!has_next) break;
#pragma unroll
        for (int a = 0; a < 2; ++a)
#pragma unroll
            for (int b = 0; b < 2; ++b)
#pragma unroll
                for (int m = 0; m < 4; ++m)
#pragma unroll
                    for (int n = 0; n < 2; ++n) acc[a][b][m][n] = (f32x4){0.f, 0.f, 0.f, 0.f};
        cur = nxt; cA = nA; cB = nB; ++ui;
        if constexpr (ALIGN_EPI) { if (wr == 1) PG8_BAR; }
    }
    PG8_WAIT_V(0);
    if constexpr (!ALIGN_EPI) { if (wr == 0) PG8_BAR; }
    PG8_BAR;
    if constexpr (Epi::AFTER_DRAIN) { E.fused(acc, cur, wr, wc, fr, fq, lds, wid, lane); S.done(cur); }
#undef PG8_SA
#undef PG8_SB
#undef PG8_STAGE
#undef PG8_LDA
#undef PG8_LDB
#undef PG8_MMA
#undef PG8_WAIT_V
#undef PG8_WAIT_L
#undef PG8_BAR
#undef PG8_SCHED
}
}

constexpr int DM = 1024, NSEQ_P = 16, TP = 2048, NSEQ_S = 32, TS = 32, PAST = 2048;
constexpr int MROWS = NSEQ_P * TP + NSEQ_S * TS;
constexpr int NH = 4, INCOLS = 2560, DFF = 4096, CW = 31, CPAD = 30, WB = 512;
constexpr float EPS = 1e-6f, LAM_INIT = 0.2f;
constexpr float LOG2E = 1.4426950408889634f;
constexpr size_t O_YP = 0, O_YS = (size_t)NSEQ_P * TP * DM, O_KP = O_YS + (size_t)NSEQ_S * TS * DM, O_VP = O_KP + (size_t)NSEQ_P * TP * 512,
                 O_CP = O_VP + (size_t)NSEQ_P * TP * 512, O_KS = O_CP + (size_t)NSEQ_P * CPAD * WB, O_VS = O_KS + (size_t)NSEQ_S * TS * 512,
                 O_CS = O_VS + (size_t)NSEQ_S * TS * 512, O_END = O_CS + (size_t)NSEQ_S * CPAD * WB;
static_assert(O_END == 69943296, "output size");
constexpr size_t MiB = 1u << 20;
constexpr size_t WS_CTL = 0, CTL_ZERO_BYTES = 1 * MiB;
constexpr size_t WS_SSQ = 1 * MiB + 512 * 1024;
constexpr size_t WS_WIN = 4 * MiB, WS_WOUT = 9 * MiB, WS_WUP = 11 * MiB, WS_WDN = 19 * MiB;
constexpr size_t WS_XN = 27 * MiB;
constexpr size_t WS_H = 93 * MiB;
constexpr size_t WS_Q = 93 * MiB, WS_KP = 126 * MiB, WS_VP = 158 * MiB, WS_KC = 190 * MiB, WS_VC = 256 * MiB, WS_U = 322 * MiB, WS_AC = 355 * MiB, WS_END = 421 * MiB;
static_assert(WS_SSQ + (size_t)MROWS * 16 * 4 <= WS_WIN && WS_WDN + (size_t)DM * DFF * 2 <= WS_XN && WS_XN + (size_t)MROWS * DM * 2 <= WS_H && WS_H + (size_t)MROWS * DFF * 2 <= WS_END && WS_KC + (size_t)NSEQ_S * pg8::KC_ROWS * 512 * 2 <= WS_VC && WS_VC + (size_t)NSEQ_S * pg8::KC_ROWS * 512 * 2 <= WS_U && WS_U + (size_t)MROWS * 512 * 2 <= WS_AC && WS_AC + (size_t)MROWS * DM * 2 <= WS_END, "ws map");
constexpr int CW_TMO = 0, CW_CODE = 1, CW_BAR = 4096;

constexpr int RING_OFF = 0, RING_BYTES = 131072;
constexpr int LDSCTL_OFF = RING_BYTES, MISC_OFF = LDSCTL_OFF + 320;
constexpr int LDS_BYTES = 147456;
constexpr int NWAVES = 8;

#define GAS __attribute__((address_space(1)))
#define LAS __attribute__((address_space(3)))
typedef unsigned short bf16;
typedef unsigned v4u __attribute__((ext_vector_type(4)));
typedef float f32x4 __attribute__((ext_vector_type(4)));
typedef float f32x16 __attribute__((ext_vector_type(16)));
typedef short bf16x8 __attribute__((ext_vector_type(8)));
typedef short s16x4 __attribute__((ext_vector_type(4)));
typedef GAS unsigned gu32;
#define RLX_AGENT __ATOMIC_RELAXED, __HIP_MEMORY_SCOPE_AGENT
#define LDS_WAIT() asm volatile("s_waitcnt lgkmcnt(0)" ::: "memory")
#define VM_WAIT() asm volatile("s_waitcnt vmcnt(0)" ::: "memory")
__device__ __forceinline__ unsigned f2bf(float f) { unsigned u = __builtin_bit_cast(unsigned, f); return (u + 0x7fffu + ((u >> 16) & 1u)) >> 16; }
__device__ __forceinline__ unsigned pk2(float lo, float hi) { return f2bf(lo) | (f2bf(hi) << 16); }
__device__ __forceinline__ float bf2f(unsigned short h) { return __builtin_bit_cast(float, (unsigned)h << 16); }

__device__ __forceinline__ float dpp_row_sum(float v) {
    v += __builtin_bit_cast(float, __builtin_amdgcn_update_dpp(0, __builtin_bit_cast(int, v), 0xB1, 0xF, 0xF, true));
    v += __builtin_bit_cast(float, __builtin_amdgcn_update_dpp(0, __builtin_bit_cast(int, v), 0x4E, 0xF, 0xF, true));
    v += __builtin_bit_cast(float, __builtin_amdgcn_update_dpp(0, __builtin_bit_cast(int, v), 0x141, 0xF, 0xF, true));
    v += __builtin_bit_cast(float, __builtin_amdgcn_update_dpp(0, __builtin_bit_cast(int, v), 0x140, 0xF, 0xF, true));
    return v;
}
__device__ __forceinline__ float dpp_wave_sum63(float v) {
    v = dpp_row_sum(v);
    v += __builtin_bit_cast(float, __builtin_amdgcn_update_dpp(0, __builtin_bit_cast(int, v), 0x142, 0xA, 0xF, false));
    v += __builtin_bit_cast(float, __builtin_amdgcn_update_dpp(0, __builtin_bit_cast(int, v), 0x143, 0xC, 0xF, false));
    return v;
}

namespace att {
constexpr int SLOTK = 16384, SLOTV = 16384;
constexpr int L_K = 0, L_V = 2 * SLOTK;
constexpr int L_TAB = RING_BYTES + 1024, L_WS = L_TAB + 4 * 192 * 4, L_ML = L_WS + 2048, L_END = L_ML + 2048;
static_assert(L_V + 2 * SLOTV <= RING_BYTES && L_END <= LDS_BYTES && L_TAB >= MISC_OFF + 128, "attention LDS");
__device__ __forceinline__ int crow(int r, int hi) { return (r & 3) + 8 * (r >> 2) + 4 * hi; }
typedef float f32x2_t __attribute__((ext_vector_type(2))); typedef __bf16 bf16x2_t __attribute__((ext_vector_type(2)));
__device__ __forceinline__ unsigned cvtpk_s(float lo, float hi) { f32x2_t v = {lo, hi}; bf16x2_t b = __builtin_convertvector(v, bf16x2_t); return __builtin_bit_cast(unsigned, b); }
typedef short v4i16_t __attribute__((ext_vector_type(4)));
__device__ __forceinline__ s16x4 vtr(const LAS unsigned char* p) { return __builtin_bit_cast(s16x4, __builtin_amdgcn_ds_read_tr16_b64_v4i16((LAS v4i16_t*)p)); }
__device__ __forceinline__ void glds(const bf16* g, LAS unsigned char* l) { __builtin_amdgcn_global_load_lds((const unsigned*)g, (LAS unsigned*)l, 16, 0, 0); }
__device__ __forceinline__ int t5_bucket(int delta) {
    int n = -delta, ret = 0; if (n < 0) { ret = 16; n = -n; }
    const int v = n < 8 ? n : (n < 12 ? 8 : n < 16 ? 9 : n < 23 ? 10 : n < 32 ? 11 : n < 46 ? 12 : n < 64 ? 13 : n < 91 ? 14 : 15);
    return ret + v;
}
struct AUnit { const bf16* Q; const bf16* K; const bf16* V; bf16* O; int h, NT, nkeys, qpos0, nrb; };

__device__ __forceinline__ void attn_unit(const AUnit& u, LAS unsigned char* lds, float lam, const float* __restrict__ subg) {
    const int tid = threadIdx.x, lane = tid & 63, r32 = lane & 31, hi = lane >> 5;
    const int wid = __builtin_amdgcn_readfirstlane(tid >> 6), mp = wid & 1, rb = wid >> 1;
    const bool active = rb < u.nrb;
    const int qbase = u.qpos0 + 32 * rb, chunk = qbase >> 6;
    LAS float* wsf = (LAS float*)(lds + L_WS) + wid * 64;
    const LAS float* tab = (const LAS float*)(lds + L_TAB) + u.h * 192;
    const bf16* ksrc = u.K + (size_t)lane * 512 + u.h * 128 + wid * 8;
    const bf16* vsrc = u.V + (size_t)(16 * (wid & 3) + (lane >> 2)) * 512 + u.h * 128 + (wid >> 2) * 32 + (lane & 3) * 8;
#define ATT_DMA(t, slot) do { const size_t go_ = (size_t)(t) * 64 * 512; \
        glds(ksrc + go_, lds + L_K + (slot) * SLOTK + wid * 1024); glds(ksrc + go_ + 64, lds + L_K + (slot) * SLOTK + 8192 + wid * 1024); \
        glds(vsrc + go_, lds + L_V + (slot) * SLOTV + wid * 1024); glds(vsrc + go_ + 64, lds + L_V + (slot) * SLOTV + 8192 + wid * 1024); } while (0)
    bf16x8 qr[4];
#pragma unroll
    for (int d0 = 0; d0 < 4; ++d0) qr[d0] = active ? *(const bf16x8*)(u.Q + (size_t)(32 * rb + r32) * 512 + u.h * 128 + mp * 64 + d0 * 16 + hi * 8) : (bf16x8){0, 0, 0, 0, 0, 0, 0, 0};
    float m = -1e30f, l = 0.f; f32x16 o[4];
#pragma unroll
    for (int d = 0; d < 4; ++d) o[d] = f32x16{};
    ATT_DMA(0, 0);
    for (int t = 0; t < u.NT; ++t) {
        asm volatile("s_waitcnt vmcnt(0) lgkmcnt(0)\n\ts_barrier" ::: "memory");
        if (t + 1 < u.NT) ATT_DMA(t + 1, (t + 1) & 1);
        if (active && t <= chunk) {
            const int slot = t & 1;
            const LAS unsigned char* kb = lds + L_K + slot * SLOTK + mp * 8192 + hi * 1024 + r32 * 16;
            f32x16 p0 = f32x16{}, p1 = f32x16{};
#pragma unroll
            for (int d0 = 0; d0 < 4; ++d0) { const bf16x8 b0 = *(const LAS bf16x8*)(kb + d0 * 2048), b1 = *(const LAS bf16x8*)(kb + d0 * 2048 + 512);
                p0 = __builtin_amdgcn_mfma_f32_32x32x16_bf16(b0, qr[d0], p0, 0, 0, 0); p1 = __builtin_amdgcn_mfma_f32_32x32x16_bf16(b1, qr[d0], p1, 0, 0, 0); }
            const int kq = 64 * t - qbase;
            if (kq + 63 <= -128) { const float c = tab[0];
#pragma unroll
                for (int r = 0; r < 16; ++r) { p0[r] += c; p1[r] += c; } }
            else { const int dl = kq - r32 + 128;
#pragma unroll
                for (int r = 0; r < 16; ++r) { const int j = dl + crow(r, hi); const int i0 = min(max(j, 0), 191), i1 = min(max(j + 32, 0), 191); p0[r] += tab[i0]; p1[r] += tab[i1]; } }
            if (64 * t + 64 > u.nkeys) {
#pragma unroll
                for (int r = 0; r < 16; ++r) { const int j = 64 * t + crow(r, hi); if (j >= u.nkeys) p0[r] = -1e30f; if (j + 32 >= u.nkeys) p1[r] = -1e30f; } }
            float rm = fmaxf(p0[0], p1[0]);
#pragma unroll
            for (int r = 1; r < 16; ++r) rm = fmaxf(rm, fmaxf(p0[r], p1[r]));
            { auto rr = __builtin_amdgcn_permlane32_swap(__float_as_uint(rm), __float_as_uint(rm), false, false); rm = fmaxf(__uint_as_float(rr[0]), __uint_as_float(rr[1])); }
            const float mn = fmaxf(m, rm), alpha = __builtin_amdgcn_exp2f(m - mn); m = mn;
            float rs = 0.f;
#pragma unroll
            for (int r = 0; r < 16; ++r) { p0[r] = __builtin_amdgcn_exp2f(p0[r] - mn); p1[r] = __builtin_amdgcn_exp2f(p1[r] - mn); rs += p0[r] + p1[r]; }
            l = l * alpha + rs;
            if (__builtin_amdgcn_ballot_w64(alpha != 1.0f) != 0ull) {
                if (hi == 0) wsf[r32] = alpha;
#pragma unroll
                for (int r = 0; r < 16; ++r) { const float a = wsf[crow(r, hi)];
#pragma unroll
                    for (int d = 0; d < 4; ++d) o[d][r] *= a; }
            }
            v4u pw[4];
#pragma unroll
            for (int i = 0; i < 4; ++i) { pw[0][i] = cvtpk_s(p0[2 * i], p0[2 * i + 1]); pw[1][i] = cvtpk_s(p0[8 + 2 * i], p0[9 + 2 * i]); pw[2][i] = cvtpk_s(p1[2 * i], p1[2 * i + 1]); pw[3][i] = cvtpk_s(p1[8 + 2 * i], p1[9 + 2 * i]); }
            const LAS unsigned char* vp = lds + L_V + slot * SLOTV + ((lane >> 4) & 1) * 32 + (lane & 3) * 8 + (4 * hi + ((lane & 15) >> 2)) * 64;
#pragma unroll
            for (int d = 0; d < 4; ++d)
#pragma unroll
                for (int ks = 0; ks < 4; ++ks) { const s16x4 lo = vtr(vp + d * 4096 + ks * 1024), h4 = vtr(vp + d * 4096 + ks * 1024 + 512);
                    const bf16x8 vf = (bf16x8){lo[0], lo[1], lo[2], lo[3], h4[0], h4[1], h4[2], h4[3]};
                    o[d] = __builtin_amdgcn_mfma_f32_32x32x16_bf16(__builtin_bit_cast(bf16x8, pw[ks]), vf, o[d], 0, 0, 0); }
        }
    }
#undef ATT_DMA
    __syncthreads();
    { auto rr = __builtin_amdgcn_permlane32_swap(__float_as_uint(l), __float_as_uint(l), false, false); l = __uint_as_float(rr[0]) + __uint_as_float(rr[1]); }
    if (active) {
        if (hi == 0) wsf[r32] = 1.0f / l;
#pragma unroll
        for (int r = 0; r < 16; ++r) { const float a = wsf[crow(r, hi)];
#pragma unroll
            for (int d = 0; d < 4; ++d) o[d][r] *= a; }
        if (mp == 1) { LAS float* X = (LAS float*)lds + rb * 4096;
#pragma unroll
            for (int d = 0; d < 4; ++d)
#pragma unroll
                for (int r = 0; r < 16; ++r) X[(d * 16 + r) * 64 + lane] = o[d][r]; }
    }
    __syncthreads();
    if (active && mp == 0) {
        const LAS float* X = (const LAS float*)lds + rb * 4096;
        float ss[16];
#pragma unroll
        for (int r = 0; r < 16; ++r) ss[r] = 0.f;
#pragma unroll
        for (int d = 0; d < 4; ++d)
#pragma unroll
            for (int r = 0; r < 16; ++r) { const float a = o[d][r] - lam * X[(d * 16 + r) * 64 + lane]; o[d][r] = a; ss[r] += a * a; }
#pragma unroll
        for (int off = 1; off < 32; off <<= 1)
#pragma unroll
            for (int r = 0; r < 16; ++r) ss[r] += __shfl_xor(ss[r], off);
        float g[4];
#pragma unroll
        for (int d = 0; d < 4; ++d) g[d] = subg[32 * d + r32] * (1.0f - LAM_INIT);
#pragma unroll
        for (int r = 0; r < 16; ++r) { const float rstd = 1.0f / sqrtf(ss[r] * (1.0f / 128.0f) + EPS); bf16* op = u.O + (size_t)(32 * rb + crow(r, hi)) * 1024 + u.h * 128 + r32;
#pragma unroll
            for (int d = 0; d < 4; ++d) op[32 * d] = (bf16)f2bf(o[d][r] * rstd * g[d]); }
    }
    __syncthreads();
}
}

namespace atts {
using att::crow; using att::cvtpk_s; using att::vtr; typedef unsigned u32x2_t __attribute__((ext_vector_type(2)));
constexpr int NTILE = 65, NIT = 17;
struct SUnit { const float* Kc; const float* Vc; const float* Kn; const float* Vn; const bf16* Q; bf16* O; int h; };
__device__ __forceinline__ void sattn_unit(const SUnit& u, LAS unsigned char* lds, float lam, const float* __restrict__ subg) {
    const int tid = threadIdx.x, lane = tid & 63, r32 = lane & 31, hi = lane >> 5;
    const int wid = __builtin_amdgcn_readfirstlane(tid >> 6), mp = wid & 1, kvq = wid >> 1;
    LAS float* wsf = (LAS float*)(lds + att::L_WS) + wid * 64;
    const LAS float* tab = (const LAS float*)(lds + att::L_TAB) + u.h * 192;
    LAS unsigned char* vslot = lds + kvq * 16384;
    bf16x8 qr[4];
#pragma unroll
    for (int d0 = 0; d0 < 4; ++d0) qr[d0] = *(const bf16x8*)(u.Q + (size_t)r32 * 512 + u.h * 128 + mp * 64 + d0 * 16 + hi * 8);
    const int koff = r32 * 512 + u.h * 128 + mp * 64 + 8 * hi;
    const int voff = (lane >> 4) * 512 + u.h * 128 + 64 * mp + 4 * (lane & 15);
    const int vwoff = (2 * mp + ((lane & 15) >> 3)) * 2048 + (lane >> 4) * 64 + (lane & 7) * 8;
    const int vroff = ((lane >> 4) & 1) * 32 + (lane & 3) * 8 + (4 * hi + ((lane & 15) >> 2)) * 64;
    const int nt = (kvq == 3) ? 17 : 16;
    f32x4 kf[8], vf[8]; bf16x8 kb[4];
#define ATS_ROWS(T, KP, VP) const float* KP = ((T) < 64) ? u.Kc + (size_t)(T) * 32 * 512 : u.Kn; const float* VP = ((T) < 64) ? u.Vc + (size_t)(T) * 32 * 512 : u.Vn
#define ATS_LOAD(T) do { ATS_ROWS(T, kp_, vp_); _Pragma("unroll") for (int d0 = 0; d0 < 4; ++d0) { kf[2 * d0] = *(const f32x4*)(kp_ + koff + 16 * d0); kf[2 * d0 + 1] = *(const f32x4*)(kp_ + koff + 16 * d0 + 4); } \
        _Pragma("unroll") for (int e = 0; e < 8; ++e) vf[e] = *(const f32x4*)(vp_ + voff + e * 4 * 512); } while (0)
#define ATS_CVT(slot) do { _Pragma("unroll") for (int d0 = 0; d0 < 4; ++d0) { v4u w; w.x = cvtpk_s(kf[2 * d0][0], kf[2 * d0][1]); w.y = cvtpk_s(kf[2 * d0][2], kf[2 * d0][3]); w.z = cvtpk_s(kf[2 * d0 + 1][0], kf[2 * d0 + 1][1]); w.w = cvtpk_s(kf[2 * d0 + 1][2], kf[2 * d0 + 1][3]); kb[d0] = __builtin_bit_cast(bf16x8, w); } \
        _Pragma("unroll") for (int e = 0; e < 8; ++e) { u32x2_t w; w.x = cvtpk_s(vf[e][0], vf[e][1]); w.y = cvtpk_s(vf[e][2], vf[e][3]); *(LAS u32x2_t*)(vslot + (slot) * 8192 + vwoff + e * 256) = w; } } while (0)
    float m = -1e30f, l = 0.f; f32x16 o[4];
#pragma unroll
    for (int d = 0; d < 4; ++d) o[d] = f32x16{};
    ATS_LOAD(16 * kvq); ATS_CVT(0);
    __syncthreads();
    for (int i = 0; i < NIT; ++i) {
        const bool have = i < nt, havenext = i + 1 < nt;
        if (havenext) ATS_LOAD(16 * kvq + i + 1);
        if (have) {
            const int slot = i & 1, k0 = 32 * (16 * kvq + i);
            f32x16 p = f32x16{};
#pragma unroll
            for (int d0 = 0; d0 < 4; ++d0) p = __builtin_amdgcn_mfma_f32_32x32x16_bf16(kb[d0], qr[d0], p, 0, 0, 0);
            const int kq = k0 - PAST;
            if (kq + 31 <= -128) { const float c = tab[0];
#pragma unroll
                for (int r = 0; r < 16; ++r) p[r] += c; }
            else { const int dl = kq - r32 + 128;
#pragma unroll
                for (int r = 0; r < 16; ++r) { const int j = dl + crow(r, hi); p[r] += tab[min(max(j, 0), 191)]; } }
            float rm = p[0];
#pragma unroll
            for (int r = 1; r < 16; ++r) rm = fmaxf(rm, p[r]);
            { auto rr = __builtin_amdgcn_permlane32_swap(__float_as_uint(rm), __float_as_uint(rm), false, false); rm = fmaxf(__uint_as_float(rr[0]), __uint_as_float(rr[1])); }
            const float mn = fmaxf(m, rm), alpha = __builtin_amdgcn_exp2f(m - mn); m = mn;
            float rs = 0.f;
#pragma unroll
            for (int r = 0; r < 16; ++r) { p[r] = __builtin_amdgcn_exp2f(p[r] - mn); rs += p[r]; }
            l = l * alpha + rs;
            if (__builtin_amdgcn_ballot_w64(alpha != 1.0f) != 0ull) {
                if (hi == 0) wsf[r32] = alpha;
#pragma unroll
                for (int r = 0; r < 16; ++r) { const float a = wsf[crow(r, hi)];
#pragma unroll
                    for (int d = 0; d < 4; ++d) o[d][r] *= a; }
            }
            v4u pw[2];
#pragma unroll
            for (int q = 0; q < 4; ++q) { pw[0][q] = cvtpk_s(p[2 * q], p[2 * q + 1]); pw[1][q] = cvtpk_s(p[8 + 2 * q], p[9 + 2 * q]); }
            const LAS unsigned char* vp = vslot + slot * 8192 + vroff;
#pragma unroll
            for (int d = 0; d < 4; ++d)
#pragma unroll
                for (int ks = 0; ks < 2; ++ks) { const s16x4 lo = vtr(vp + d * 2048 + ks * 1024), h4 = vtr(vp + d * 2048 + ks * 1024 + 512);
                    const bf16x8 vv = (bf16x8){lo[0], lo[1], lo[2], lo[3], h4[0], h4[1], h4[2], h4[3]};
                    o[d] = __builtin_amdgcn_mfma_f32_32x32x16_bf16(__builtin_bit_cast(bf16x8, pw[ks]), vv, o[d], 0, 0, 0); }
        }
        if (havenext) ATS_CVT((i + 1) & 1);
        __syncthreads();
    }
#undef ATS_ROWS
#undef ATS_LOAD
#undef ATS_CVT
    { auto rr = __builtin_amdgcn_permlane32_swap(__float_as_uint(l), __float_as_uint(l), false, false); l = __uint_as_float(rr[0]) + __uint_as_float(rr[1]); }
    { LAS float* X = (LAS float*)lds + wid * 4096;
#pragma unroll
        for (int d = 0; d < 4; ++d)
#pragma unroll
            for (int r = 0; r < 16; ++r) X[(d * 16 + r) * 64 + lane] = o[d][r];
        LAS float* ML = (LAS float*)(lds + att::L_ML) + wid * 64;
        if (hi == 0) { ML[2 * r32] = m; ML[2 * r32 + 1] = l; } }
    __syncthreads();
    {
        const int q = 4 * wid + (lane >> 4), g = lane & 15, d0 = 8 * g;
        const int qhi = (q >> 2) & 1, qr_ = (q & 3) + 4 * (q >> 3);
        const int eoff = ((d0 >> 5) * 16 + qr_) * 64 + (d0 & 31) + 32 * qhi;
        float a[2][8];
#pragma unroll
        for (int mm = 0; mm < 2; ++mm) {
            float mw[4], lw[4], M = -1e30f;
#pragma unroll
            for (int k = 0; k < 4; ++k) { const LAS float* ML = (const LAS float*)(lds + att::L_ML) + (2 * k + mm) * 64; mw[k] = ML[2 * q]; lw[k] = ML[2 * q + 1]; M = fmaxf(M, mw[k]); }
            float L = 0.f, sc[4];
#pragma unroll
            for (int k = 0; k < 4; ++k) { sc[k] = __builtin_amdgcn_exp2f(mw[k] - M); L += sc[k] * lw[k]; }
            const float inv = 1.0f / L;
#pragma unroll
            for (int j = 0; j < 8; ++j) { float acc = 0.f;
#pragma unroll
                for (int k = 0; k < 4; ++k) acc += sc[k] * ((const LAS float*)lds)[(2 * k + mm) * 4096 + eoff + j];
                a[mm][j] = acc * inv; }
        }
        float ss = 0.f, v[8];
#pragma unroll
        for (int j = 0; j < 8; ++j) { v[j] = a[0][j] - lam * a[1][j]; ss += v[j] * v[j]; }
        ss = dpp_row_sum(ss);
        const float rstd = 1.0f / sqrtf(ss * (1.0f / 128.0f) + EPS) * (1.0f - LAM_INIT);
        const f32x4 g0 = *(const f32x4*)(subg + d0), g1 = *(const f32x4*)(subg + d0 + 4);
        v4u w; w.x = cvtpk_s(v[0] * rstd * g0[0], v[1] * rstd * g0[1]); w.y = cvtpk_s(v[2] * rstd * g0[2], v[3] * rstd * g0[3]); w.z = cvtpk_s(v[4] * rstd * g1[0], v[5] * rstd * g1[1]); w.w = cvtpk_s(v[6] * rstd * g1[2], v[7] * rstd * g1[3]);
        *(v4u*)(u.O + (size_t)q * 1024 + u.h * 128 + d0) = w;
    }
    __syncthreads();
}
}
#define XB_TMO      128
#define XB_XCNT(j)  (256  + 64 * (j))
#define XB_XSUB(j)  (1280 + 64 * (j))
#define XB_XGEN(j)  (2304 + 64 * (j))
#define XB_TOP      3328
#define XB_TOPGEN   3392
#define XCD_BAR_WORDS 3456
#define XB_SPIN_CAP (1u << 18)

__device__ __forceinline__ unsigned xb_ld(unsigned* p)              { return __hip_atomic_load(p, __ATOMIC_RELAXED, __HIP_MEMORY_SCOPE_AGENT); }
__device__ __forceinline__ unsigned xb_add(unsigned* p, unsigned v) { return __hip_atomic_fetch_add(p, v, __ATOMIC_RELAXED, __HIP_MEMORY_SCOPE_AGENT); }
__device__ __forceinline__ unsigned xb_xcc_id() { return (unsigned)__builtin_amdgcn_s_getreg((3 << 11) | 20) & 0xFu; }
#define XB_SPIN(cond, bar) do { unsigned _sp = 0; while (cond) { __builtin_amdgcn_s_sleep(1); \
    if ((++_sp & 255u) == 0u) { if (xb_ld(&(bar)[XB_TMO])) break; if (_sp > XB_SPIN_CAP) { atomicAdd(&(bar)[XB_TMO], 1u); break; } } } } while (0)

struct XcdBarrier {
    unsigned* bar; unsigned x;
    volatile LAS unsigned* st;
};

__device__ __forceinline__ XcdBarrier xcd_barrier_post(unsigned* bar, volatile LAS unsigned* st) {
    XcdBarrier b; b.bar = bar; b.x = xb_xcc_id(); b.st = st;
    if (threadIdx.x == 0) (void)xb_add(&bar[XB_XCNT(b.x)], 1u);
    return b;
}
__device__ __forceinline__ void xcd_barrier_complete(unsigned* bar, unsigned x, unsigned& nloc, unsigned& nx) {
    const unsigned G = gridDim.x * gridDim.y * gridDim.z;
    unsigned sum, cnt, mine, sp = 0u;
    for (;;) {
        sum = 0u; cnt = 0u; mine = 0u;
#pragma unroll
        for (unsigned j = 0; j < 16; ++j) { const unsigned c = xb_ld(&bar[XB_XCNT(j)]); sum += c; cnt += (c > 0u) ? 1u : 0u; mine = (j == x) ? c : mine; }
        if (sum == G) break;
        __builtin_amdgcn_s_sleep(1);
        if ((++sp & 255u) == 0u) { if (xb_ld(&bar[XB_TMO])) break; if (sp > XB_SPIN_CAP) { atomicAdd(&bar[XB_TMO], 1u); break; } }
    }
    nloc = mine > 0u ? mine : 1u; nx = cnt > 0u ? cnt : 1u;
}

__device__ __forceinline__ void xcd_barrier(const XcdBarrier& b) {
    asm volatile("s_waitcnt vmcnt(0)" ::: "memory");
    __syncthreads();
    if (threadIdx.x == 0) {
        unsigned* bar = b.bar;
        __builtin_amdgcn_s_waitcnt(0);
        unsigned nloc = b.st[0], nx = b.st[1];
        if (nloc == 0u) { xcd_barrier_complete(bar, b.x, nloc, nx); b.st[0] = nloc; b.st[1] = nx; }
        const unsigned old = xb_add(&bar[XB_XSUB(b.x)], 1u);
        const unsigned gen = old / nloc;
        if (old + 1u == (gen + 1u) * nloc) {
            __builtin_amdgcn_fence(__ATOMIC_RELEASE, "agent");
            asm volatile("s_waitcnt vmcnt(0)" ::: "memory");
            const unsigned og = xb_add(&bar[XB_TOP], 1u);
            const unsigned tg = og / nx;
            if (og + 1u == (tg + 1u) * nx) xb_add(&bar[XB_TOPGEN], 1u);
            else XB_SPIN(xb_ld(&bar[XB_TOPGEN]) == tg, bar);
            __builtin_amdgcn_fence(__ATOMIC_ACQUIRE, "agent");
            xb_add(&bar[XB_XGEN(b.x)], 1u);
            asm volatile("s_waitcnt vmcnt(0)" ::: "memory");
        } else {
            XB_SPIN(xb_ld(&bar[XB_XGEN(b.x)]) == gen, bar);
            __builtin_amdgcn_fence(__ATOMIC_ACQUIRE, "agent");
            asm volatile("s_waitcnt vmcnt(0)" ::: "memory");
        }
    }
    __syncthreads();
}

struct Frame {
    LAS unsigned char* lds;
    volatile LAS unsigned* MISC;
    gu32* ctl;
    int tid, lane, wave;
    int vcu, G;
    const float *xp, *xs, *cache_k, *cache_v, *state_conv, *rel_bias, *ln1_g, *w_in, *lq1, *lk1, *lq2, *lk2, *subln_g, *w_dw, *b_dw, *cln_g, *cln_b, *w_out, *ln2_g, *w_up, *w_down, *lnf_g;
    float* out;
    bf16 *Win_t, *Wout_t, *Wup_t, *Wdn_t, *XN, *Q, *Kp, *Vp, *Kc, *Vc, *U, *AC, *H; float* ssq;
};
__device__ __forceinline__ float wave_sum(float v) {
#pragma unroll
    for (int o = 1; o < 64; o <<= 1) v += __shfl_xor(v, o);
    return v;
}
__device__ __forceinline__ void p0_transpose_item(const float* W, int K, int N, bf16* WT, LAS float* scr, int k0, int n0, int sn0, int lane, const float* kgain = nullptr) {
#pragma unroll 8
    for (int i = 0; i < 32; ++i) { const int kk = 2 * i + (lane >> 5); const float gk = kgain ? kgain[k0 + kk] : 1.0f; scr[kk * 33 + (lane & 31)] = W[(size_t)(k0 + kk) * N + sn0 + (lane & 31)] * gk; }
    LDS_WAIT(); asm volatile("" ::: "memory");
    const int c = lane & 7;
#pragma unroll
    for (int j = 0; j < 4; ++j) { const int n = (lane >> 3) + 8 * j; const LAS float* s = scr + (8 * c) * 33 + n;
        v4u o; o.x = pk2(s[0 * 33], s[1 * 33]); o.y = pk2(s[2 * 33], s[3 * 33]); o.z = pk2(s[4 * 33], s[5 * 33]); o.w = pk2(s[6 * 33], s[7 * 33]);
        *(GAS v4u*)(WT + (size_t)(n0 + n) * K + k0 + 8 * c) = o; }
    LDS_WAIT(); asm volatile("" ::: "memory");
}
__device__ __forceinline__ int win_src_col(int n0) {
    if (n0 < 1536) return n0;
    const int j = n0 - 1536, t = j >> 8, jj = j & 255;
    return jj < 128 ? 1536 + 128 * t + jj : 2048 + 128 * t + (jj - 128);
}
template <bool BF> __device__ __forceinline__ void rms_row(const float* xrow, const float* g, void* orow, int lane) {
    const GAS f32x4* xr = (const GAS f32x4*)xrow + lane; const GAS f32x4* gr = (const GAS f32x4*)g + lane;
    f32x4 v[4]; float s = 0.f;
#pragma unroll
    for (int j = 0; j < 4; ++j) { v[j] = xr[64 * j]; s += (v[j].x * v[j].x + v[j].y * v[j].y) + (v[j].z * v[j].z + v[j].w * v[j].w); }
    const float rstd = 1.0f / sqrtf(wave_sum(s) * (1.0f / 1024.0f) + EPS);
#pragma unroll
    for (int j = 0; j < 4; ++j) { const f32x4 gg = gr[64 * j]; const f32x4 y = v[j] * rstd * gg;
        if (BF) ((GAS unsigned long long*)orow)[lane + 64 * j] = (unsigned long long)pk2(y.x, y.y) | ((unsigned long long)pk2(y.z, y.w) << 32);
        else ((GAS f32x4*)orow)[lane + 64 * j] = y; }
}
__device__ __forceinline__ const float* x_row(const Frame& F, int R) { return R < pg8::PROMPT_ROWS ? F.xp + (size_t)R * DM : F.xs + (size_t)(R - pg8::PROMPT_ROWS) * DM; }

__device__ __forceinline__ void p0_prologue(Frame& F) {
    LAS float* scr = (LAS float*)(F.lds + RING_OFF + F.wave * 16384);
    const int gw = F.vcu * NWAVES + F.wave, NGW = F.G * NWAVES;
    constexpr int I_IN = (DM / 64) * (INCOLS / 32), I_OUT = (DM / 64) * (DM / 32), I_UP = (DM / 64) * (DFF / 32), I_DN = (DFF / 64) * (DM / 32);
    constexpr int NITEMS = I_IN + I_OUT + I_UP + I_DN;
    for (int it = gw; it < NITEMS; it += NGW) {
        int r = it;
        if (r < I_IN) { const int nb = INCOLS / 32, kb = r / nb, n0 = 32 * (r % nb); p0_transpose_item(F.w_in, DM, INCOLS, F.Win_t, scr, 64 * kb, n0, win_src_col(n0), F.lane); continue; } r -= I_IN;
        if (r < I_OUT) { const int nb = DM / 32, kb = r / nb, n0 = 32 * (r % nb); p0_transpose_item(F.w_out, DM, DM, F.Wout_t, scr, 64 * kb, n0, n0, F.lane); continue; } r -= I_OUT;
        if (r < I_UP) { const int nb = DFF / 32, kb = r / nb, n0 = 32 * (r % nb); p0_transpose_item(F.w_up, DM, DFF, F.Wup_t, scr, 64 * kb, n0, n0, F.lane, F.ln2_g); continue; } r -= I_UP;
        { const int nb = DM / 32, kb = r / nb, n0 = 32 * (r % nb); p0_transpose_item(F.w_down, DFF, DM, F.Wdn_t, scr, 64 * kb, n0, n0, F.lane); }
    }
    for (int R = gw; R < MROWS; R += NGW) rms_row<true>(x_row(F, R), F.ln1_g, F.XN + (size_t)R * DM, F.lane);
}

__device__ __forceinline__ float attn_setup(Frame& F) {
    LAS float* tab = (LAS float*)(F.lds + att::L_TAB);
    for (int i = F.tid; i < 4 * 192; i += NWAVES * 64) { const int h = i / 192, d = i % 192 - 128; tab[i] = F.rel_bias[att::t5_bucket(d) * NH + h] * LOG2E; }
    float s1 = 0.f, s2 = 0.f;
    for (int i = 0; i < 64; ++i) { s1 += F.lq1[i] * F.lk1[i]; s2 += F.lq2[i] * F.lk2[i]; }
    __syncthreads();
    return expf(s1) - expf(s2) + LAM_INIT;
}
__device__ __forceinline__ void prompt_attn_unit(Frame& F, int bh, int qb, float lam) {
    const int b = bh >> 2, h = bh & 3;
    att::AUnit u; u.Q = F.Q + (size_t)(b * TP + 128 * qb) * 512; u.K = F.Kp + (size_t)b * TP * 512; u.V = F.Vp + (size_t)b * TP * 512; u.O = F.AC + (size_t)(b * TP + 128 * qb) * 1024;
    u.h = h; u.NT = 2 * qb + 2; u.nkeys = 64 * u.NT; u.qpos0 = 128 * qb; u.nrb = 4;
    att::attn_unit(u, F.lds, lam, F.subln_g);
}
__device__ __forceinline__ void sample_attn_unit(Frame& F, int su, float lam) {
    const int b = su >> 2, h = su & 3;
    atts::SUnit u; u.Kc = F.cache_k + (size_t)b * PAST * 512; u.Vc = F.cache_v + (size_t)b * PAST * 512; u.Kn = F.out + O_KS + (size_t)b * TS * 512; u.Vn = F.out + O_VS + (size_t)b * TS * 512;
    u.Q = F.Q + (size_t)(pg8::PROMPT_ROWS + b * TS) * 512; u.O = F.AC + (size_t)(pg8::PROMPT_ROWS + b * TS) * 1024; u.h = h;
    atts::sattn_unit(u, F.lds, lam, F.subln_g);
}
__device__ __forceinline__ int dequeue(Frame& F, gu32* head) {
    __syncthreads();
    if (F.tid == 0) F.MISC[16] = __hip_atomic_fetch_add(head, 1u, RLX_AGENT);
    __syncthreads();
    return (int)F.MISC[16];
}

template <int NPRE, bool HP> __device__ __forceinline__ void conv_load(float (&u0)[38], float (&u1)[38], const bf16* up, const float* pp) {
#pragma unroll
    for (int i = 0; i < 38; ++i) {
        if (i >= NPRE) { const unsigned v = *(const unsigned*)(up + (size_t)i * WB); u0[i] = __builtin_bit_cast(float, v << 16); u1[i] = __builtin_bit_cast(float, v & 0xffff0000u); }
        else if (HP) { const float2 v = *(const float2*)(pp + (size_t)i * WB); u0[i] = v.x; u1[i] = v.y; }
        else { u0[i] = 0.f; u1[i] = 0.f; } }
}
struct ConvW { float w0[CW], w1[CW]; float2 bdw, lg, lb; };
__device__ __forceinline__ void conv_load_w(Frame& F, ConvW& cw) {
    const int c = 2 * (F.tid & 255);
#pragma unroll
    for (int j = 0; j < CW; ++j) { const float2 ww = *(const float2*)(F.w_dw + j * WB + c); cw.w0[j] = ww.x; cw.w1[j] = ww.y; }
    cw.bdw = *(const float2*)(F.b_dw + c); cw.lg = *(const float2*)(F.cln_g + c); cw.lb = *(const float2*)(F.cln_b + c);
}
__device__ __forceinline__ void conv_unit(Frame& F, const ConvW& cw, int un) {
    LAS float* red = (LAS float*)(F.lds + 96 * 1024);
    LAS float* stat = red + 128;
    const int cp = F.tid & 255, rh = F.wave >> 2, c = 2 * cp;
    const float2 bdw = cw.bdw, lg = cw.lg, lb = cw.lb;
    constexpr int NU_P = NSEQ_P * (TP / 16);
    {
        int b, t0, T, rowbase; const float* pre = nullptr; float* ost;
        if (un < NU_P) { b = un / (TP / 16); t0 = (un % (TP / 16)) * 16; T = TP; rowbase = b * TP; ost = F.out + O_CP + (size_t)b * CPAD * WB; }
        else { const int s = un - NU_P; b = s >> 1; t0 = (s & 1) * 16; T = TS; rowbase = pg8::PROMPT_ROWS + b * TS; pre = F.state_conv + (size_t)b * CPAD * WB; ost = F.out + O_CS + (size_t)b * CPAD * WB; }
        const int tb = t0 + 8 * rh;
        float u0[38], u1[38];
        { const int npre = tb >= CPAD ? 0 : CPAD - tb;
            const bf16* up = F.U + (size_t)(rowbase + tb - CPAD) * WB + c; const float* pp = pre ? pre + (size_t)tb * WB + c : nullptr;
            if (npre == 0) conv_load<0, false>(u0, u1, up, pp);
            else if (pre) { if (npre == 30) conv_load<30, true>(u0, u1, up, pp); else if (npre == 22) conv_load<22, true>(u0, u1, up, pp); else if (npre == 14) conv_load<14, true>(u0, u1, up, pp); else conv_load<6, true>(u0, u1, up, pp); }
            else { if (npre == 30) conv_load<30, false>(u0, u1, up, pp); else if (npre == 22) conv_load<22, false>(u0, u1, up, pp); else if (npre == 14) conv_load<14, false>(u0, u1, up, pp); else conv_load<6, false>(u0, u1, up, pp); } }
        float y0[8], y1[8];
#pragma unroll
        for (int i = 0; i < 8; ++i) { float a0 = bdw.x, a1 = bdw.y;
#pragma unroll
            for (int j = 0; j < CW; ++j) { a0 += cw.w0[j] * u0[i + j]; a1 += cw.w1[j] * u1[i + j]; }
            y0[i] = a0; y1[i] = a1; }
#pragma unroll
        for (int i = 0; i < 8; ++i) { const float s1 = dpp_wave_sum63(y0[i] + y1[i]), s2 = dpp_wave_sum63(y0[i] * y0[i] + y1[i] * y1[i]);
            if (F.lane == 63) { red[F.wave * 16 + 2 * i] = s1; red[F.wave * 16 + 2 * i + 1] = s2; } }
        __syncthreads();
        if (F.tid < 16) { const int r = F.tid, h = r >> 3, i = r & 7; float a = 0.f, q = 0.f;
#pragma unroll
            for (int ww = 0; ww < 4; ++ww) { a += red[(4 * h + ww) * 16 + 2 * i]; q += red[(4 * h + ww) * 16 + 2 * i + 1]; }
            const float mean = a * (1.0f / WB), var = fmaxf(q * (1.0f / WB) - mean * mean, 0.f);
            stat[2 * r] = mean; stat[2 * r + 1] = 1.0f / sqrtf(var + EPS); }
        __syncthreads();
#pragma unroll
        for (int i = 0; i < 8; ++i) { const float mean = stat[2 * (8 * rh + i)], rstd = stat[2 * (8 * rh + i) + 1];
            float v0 = (y0[i] - mean) * rstd * lg.x + lb.x, v1 = (y1[i] - mean) * rstd * lg.y + lb.y; v0 = v0 * pg8::sigmoidf_fast(v0); v1 = v1 * pg8::sigmoidf_fast(v1);
            *(unsigned*)(F.AC + (size_t)(rowbase + tb + i) * 1024 + 512 + c) = pk2(v0, v1);
            const int t = tb + i; if (t >= T - CPAD) *(float2*)(ost + (size_t)(t - (T - CPAD)) * WB + c) = make_float2(u0[CPAD + i], u1[CPAD + i]); }
        __syncthreads();
    }
}

constexpr int CW_QA = 8192, CW_QC = 8192 + 1024, CW_SBAR = 8192 + 2048;
constexpr int N_SAMPLE_WG = 64;

__device__ __forceinline__ void host_phase(Frame& F) {
    const float lam = attn_setup(F);
    const int x = (int)(blockIdx.x & 7);
    gu32* qa = F.ctl + CW_QA + 64 * x; gu32* qc = F.ctl + CW_QC + 64 * x;
    for (;;) { const int a = dequeue(F, qa); if (a >= 128) break; prompt_attn_unit(F, 8 * (a & 7) + x, 15 - (a >> 3), lam); }
    ConvW cw; conv_load_w(F, cw);
    for (;;) { const int c = dequeue(F, qc); if (c >= 256) break; conv_unit(F, cw, (x + 8 * (c >> 7)) * (TP / 16) + (c & 127)); }
}

__device__ __forceinline__ void sub_barrier(Frame& F, unsigned target) {
    VM_WAIT(); __syncthreads();
    if (F.tid == 0) {
        gu32* cnt = F.ctl + CW_SBAR;
        __builtin_amdgcn_fence(__ATOMIC_RELEASE, "agent"); VM_WAIT();
        __hip_atomic_fetch_add(cnt, 1u, RLX_AGENT);
        unsigned sp = 0;
        while (__hip_atomic_load(cnt, RLX_AGENT) < target) { __builtin_amdgcn_s_sleep(1); if (++sp > (1u << 22)) { __hip_atomic_store(F.ctl + CW_TMO, 1u, RLX_AGENT); break; } }
        __builtin_amdgcn_fence(__ATOMIC_ACQUIRE, "agent"); VM_WAIT();
    }
    __syncthreads();
}

__device__ __forceinline__ void sample_chain(Frame& F, int sc, int S) {
    constexpr size_t R0 = pg8::PROMPT_ROWS;
    const float QSCALE = 0.125f * LOG2E;
    float* slab = (float*)F.Kc;
    bf16* HS = F.Vc;
    {
        pg8::Gemm g{F.XN + R0 * DM, F.Win_t, TS * NSEQ_S, INCOLS, DM, 0}; pg8::ListOrder L{40, S, sc, 10, 1};
        pg8::EpiProj E{F.Q + R0 * 512, nullptr, nullptr, F.U + R0 * 512, F.out + O_KS, F.out + O_VS, QSCALE, true};
        pg8::gemm_phase<pg8::EpiProj, pg8::ListOrder, true, true>(F.lds + RING_OFF, g, L, E);
    }
    sub_barrier(F, (unsigned)S * 1u);
    {
        const float lam = attn_setup(F);
        for (int su = sc; su < NSEQ_S * NH; su += S) sample_attn_unit(F, su, lam);
        ConvW cw; conv_load_w(F, cw);
        for (int un = NSEQ_P * (TP / 16) + sc; un < NSEQ_P * (TP / 16) + NSEQ_S * (TS / 16); un += S) conv_unit(F, cw, un);
    }
    sub_barrier(F, (unsigned)S * 2u);
    {
        pg8::Gemm g{F.AC + R0 * DM, F.Wout_t, TS * NSEQ_S, DM, DM, 0}; pg8::ListOrder L{16, S, sc, 4, 1};
        pg8::EpiRes1 E{F.xs, F.XN + R0 * DM, F.ssq + R0 * 16};
        pg8::gemm_phase<pg8::EpiRes1, pg8::ListOrder, true, true>(F.lds + RING_OFF, g, L, E);
    }
    sub_barrier(F, (unsigned)S * 3u);
    {
        pg8::Gemm g{F.XN + R0 * DM, F.Wup_t, TS * NSEQ_S, DFF, DM, 0}; pg8::ListOrder L{64, S, sc, 16, 1};
        pg8::EpiRelu2 E{HS, DFF, F.ssq + R0 * 16, EPS};
        pg8::gemm_phase<pg8::EpiRelu2, pg8::ListOrder, true, true>(F.lds + RING_OFF, g, L, E);
    }
    sub_barrier(F, (unsigned)S * 4u);
    {
        pg8::Gemm g{HS, F.Wdn_t, TS * NSEQ_S, DM, DM, DFF}; pg8::ListOrder L{64, S, sc, 4, 4};
        pg8::EpiPartial E{slab, (size_t)TS * NSEQ_S * DM};
        pg8::gemm_phase<pg8::EpiPartial, pg8::ListOrder, true, true>(F.lds + RING_OFF, g, L, E);
    }
    sub_barrier(F, (unsigned)S * 5u);
    {
        const int gw = sc * NWAVES + F.wave, NGW = S * NWAVES;
        for (int r = gw; r < TS * NSEQ_S; r += NGW) {
            const GAS unsigned long long* xb = (const GAS unsigned long long*)(F.XN + (R0 + r) * DM) + F.lane; const GAS f32x4* gr = (const GAS f32x4*)F.lnf_g + F.lane;
            f32x4 v[4]; float s = 0.f;
#pragma unroll
            for (int j = 0; j < 4; ++j) { const unsigned long long w = xb[64 * j]; const unsigned lo = (unsigned)w, hi = (unsigned)(w >> 32);
                v[j] = (f32x4){__builtin_bit_cast(float, lo << 16), __builtin_bit_cast(float, lo & 0xffff0000u), __builtin_bit_cast(float, hi << 16), __builtin_bit_cast(float, hi & 0xffff0000u)};
#pragma unroll
                for (int k = 0; k < 4; ++k) v[j] += ((const GAS f32x4*)(slab + (size_t)k * TS * NSEQ_S * DM + (size_t)r * DM))[F.lane + 64 * j];
                s += (v[j].x * v[j].x + v[j].y * v[j].y) + (v[j].z * v[j].z + v[j].w * v[j].w); }
            const float rstd = 1.0f / sqrtf(wave_sum(s) * (1.0f / 1024.0f) + EPS);
#pragma unroll
            for (int j = 0; j < 4; ++j) ((GAS f32x4*)(F.out + O_YS + (size_t)r * DM))[F.lane + 64 * j] = v[j] * rstd * gr[64 * j];
        }
    }
}

#ifndef MK_N_LAUNCHES
#define MK_N_LAUNCHES 1
#endif
constexpr int N_PHASES = 7;
constexpr int N_LAUNCHES = MK_N_LAUNCHES;
struct Args { const float* in[22]; float* out; unsigned char* ws; int ph_lo, ph_hi, li, pad; };
__global__ void __launch_bounds__(NWAVES * 64, 2) fwd_kernel(Args args) {
    extern __shared__ __attribute__((aligned(16))) unsigned char lds[];
    Frame F;
    F.lds = (LAS unsigned char*)lds;
    F.MISC = (volatile LAS unsigned*)(F.lds + MISC_OFF);
    F.tid = threadIdx.x; F.lane = F.tid & 63; F.wave = __builtin_amdgcn_readfirstlane(F.tid >> 6);
    F.G = gridDim.x; { const int bx = blockIdx.x; F.vcu = (F.G % 8 == 0) ? (bx % 8) * (F.G / 8) + bx / 8 : bx; }
    unsigned char* ws = args.ws;
    F.ctl = (gu32*)(ws + WS_CTL);
    F.xp = args.in[0]; F.xs = args.in[1]; F.cache_k = args.in[2]; F.cache_v = args.in[3]; F.state_conv = args.in[4]; F.rel_bias = args.in[5]; F.ln1_g = args.in[6]; F.w_in = args.in[7];
    F.lq1 = args.in[8]; F.lk1 = args.in[9]; F.lq2 = args.in[10]; F.lk2 = args.in[11]; F.subln_g = args.in[12]; F.w_dw = args.in[13]; F.b_dw = args.in[14]; F.cln_g = args.in[15]; F.cln_b = args.in[16];
    F.w_out = args.in[17]; F.ln2_g = args.in[18]; F.w_up = args.in[19]; F.w_down = args.in[20]; F.lnf_g = args.in[21]; F.out = args.out;
    F.Win_t = (bf16*)(ws + WS_WIN); F.Wout_t = (bf16*)(ws + WS_WOUT); F.Wup_t = (bf16*)(ws + WS_WUP); F.Wdn_t = (bf16*)(ws + WS_WDN); F.XN = (bf16*)(ws + WS_XN);
    F.Q = (bf16*)(ws + WS_Q); F.Kp = (bf16*)(ws + WS_KP); F.Vp = (bf16*)(ws + WS_VP); F.Kc = (bf16*)(ws + WS_KC); F.Vc = (bf16*)(ws + WS_VC); F.U = (bf16*)(ws + WS_U); F.AC = (bf16*)(ws + WS_AC); F.H = (bf16*)(ws + WS_H); F.ssq = (float*)(ws + WS_SSQ);
    for (int u = F.tid; u < (LDS_BYTES - LDSCTL_OFF) / 4; u += NWAVES * 64) ((LAS unsigned*)(F.lds + LDSCTL_OFF))[u] = 0u;
    __syncthreads();
    XcdBarrier bar; bar.bar = (unsigned*)(F.ctl + CW_BAR); bar.x = 0; bar.st = nullptr;
    if (N_LAUNCHES == 1) bar = xcd_barrier_post((unsigned*)(F.ctl + CW_BAR), F.MISC + 8);
    const int lo = args.ph_lo, hi = args.ph_hi;
#define IN(k) (lo <= (k) && (k) < hi)
#define SEAM(k) do { if (IN(k) && IN((k) + 1)) xcd_barrier(bar); } while (0)
#ifndef REP_PHASE
#define REP_PHASE -1
#endif
#ifndef REP_N
#define REP_N 1
#endif
#define NREP(k) (((k) == REP_PHASE) ? 1 + REP_N : 1)
    const float QSCALE = 0.125f * LOG2E;

    const int S = N_SAMPLE_WG, bx = (int)blockIdx.x;
    if (IN(0)) { p0_prologue(F); SEAM(0); }
    if (IN(1)) {
        pg8::Gemm g{F.XN, F.Win_t, pg8::PROMPT_ROWS, INCOLS, DM, 0}; pg8::StaticOrder S1; S1.init(pg8::PROMPT_ROWS, INCOLS, F.G, bx);
        pg8::EpiProj E{F.Q, F.Kp, F.Vp, F.U, F.out + O_KP, F.out + O_VP, QSCALE, false};
        pg8::gemm_phase<pg8::EpiProj, pg8::StaticOrder, true, true>(F.lds + RING_OFF, g, S1, E);
        SEAM(1);
    }
    if (IN(2)) { if (bx < F.G - S) host_phase(F); else sample_chain(F, bx - (F.G - S), S); SEAM(2); }
    if (IN(3)) {
        pg8::Gemm g{F.AC, F.Wout_t, pg8::PROMPT_ROWS, DM, DM, 0}; pg8::StaticOrder S1; S1.init(pg8::PROMPT_ROWS, DM, F.G, bx);
        pg8::EpiRes1 E{F.xp, F.XN, F.ssq};
        pg8::gemm_phase<pg8::EpiRes1, pg8::StaticOrder, true, true>(F.lds + RING_OFF, g, S1, E);
        SEAM(3);
    }
    if (IN(4)) {
        pg8::Gemm g{F.XN, F.Wup_t, pg8::PROMPT_ROWS, DFF, DM, 0}; pg8::StaticOrder S1; S1.init(pg8::PROMPT_ROWS, DFF, F.G, bx);
        pg8::EpiRelu2 E{F.H, DFF, F.ssq, EPS};
        pg8::gemm_phase<pg8::EpiRelu2, pg8::StaticOrder, true, true>(F.lds + RING_OFF, g, S1, E);
        SEAM(4);
    }
    if (IN(5)) {
        pg8::Gemm g{F.H, F.Wdn_t, pg8::PROMPT_ROWS, DM, DFF, 0}; pg8::StaticOrder S1; S1.init(pg8::PROMPT_ROWS, DM, F.G, bx);
        pg8::EpiRes2 E{F.XN, F.out};
        pg8::gemm_phase<pg8::EpiRes2, pg8::StaticOrder, true, true>(F.lds + RING_OFF, g, S1, E);
        SEAM(5);
    }
    if (IN(6)) {
        const int gw = F.vcu * NWAVES + F.wave, NGW = F.G * NWAVES;
        for (int R = gw; R < pg8::PROMPT_ROWS; R += NGW) rms_row<false>(F.out + (size_t)R * DM, F.lnf_g, F.out + (size_t)R * DM, F.lane);
    }
#undef IN
#undef SEAM
}

extern "C" void kernel_launch(void* const* d_in, const int* in_sizes, int n_in, void* d_out, int out_size, void* d_ws, size_t ws_size, hipStream_t stream) {
    static int grid = 0;
    if (grid == 0) {
        if (n_in != 22 || (size_t)out_size != O_END || ws_size < WS_END) { fprintf(stderr, "kernel_launch: unexpected shapes: n_in %d out %d ws %zu; nothing launched\n", n_in, out_size, ws_size); grid = -1; return; }
        int dev = 0, cus = 0, per_cu = 0;
        if (hipGetDevice(&dev) != hipSuccess || hipDeviceGetAttribute(&cus, hipDeviceAttributeMultiprocessorCount, dev) != hipSuccess) { fprintf(stderr, "kernel_launch: device query failed\n"); grid = -1; return; }
        if (hipFuncSetAttribute((const void*)fwd_kernel, hipFuncAttributeMaxDynamicSharedMemorySize, LDS_BYTES) != hipSuccess) { fprintf(stderr, "kernel_launch: hipFuncSetAttribute failed\n"); grid = -1; return; }
        if (hipOccupancyMaxActiveBlocksPerMultiprocessor(&per_cu, (const void*)fwd_kernel, NWAVES * 64, LDS_BYTES) != hipSuccess || per_cu < 1) { fprintf(stderr, "kernel_launch: occupancy query reports %d blocks per CU\n", per_cu); }
        (void)hipGetLastError();
        grid = cus;
        if (grid != 256) { fprintf(stderr, "kernel_launch: built for a 256-CU device, found %d CUs; nothing launched\n", cus); grid = -1; return; }
    }
    if (grid < 0) return;
    (void)hipMemsetAsync((char*)d_ws + WS_CTL, 0, CTL_ZERO_BYTES, stream);
    Args a{};
    for (int i = 0; i < 22; ++i) a.in[i] = (const float*)d_in[i];
    a.out = (float*)d_out; a.ws = (unsigned char*)d_ws;
    for (int li = 0; li < N_LAUNCHES; ++li) {
        a.ph_lo = (N_LAUNCHES == 1) ? 0 : li; a.ph_hi = (N_LAUNCHES == 1) ? N_PHASES : li + 1; a.li = li;
        hipLaunchKernelGGL(fwd_kernel, dim3(grid), dim3(NWAVES * 64), LDS_BYTES, stream, a);
    }
}
```
